# Optimizing an MI355X kernel written in HIP

```python
import math
import jax, jax.numpy as jnp
from jax import lax
import numpy as np

D_MODEL = 1024
BATCH = 4
SEQ = 4096
DEPTH = 2
DEC_BATCH = 16
DEC_SEQ = 2048
PAST_LEN = 128

MIX_WIDTH = D_MODEL
HG_WIDTH = MIX_WIDTH // 2
HG_DK = 128
HG_HEADS = HG_WIDTH // HG_DK
HG_DV = HG_WIDTH // HG_HEADS
HG_CHUNK = 64
DA_WIDTH = MIX_WIDTH - HG_WIDTH
DA_HEADS = 4
DA_HEAD_DIM = DA_WIDTH // DA_HEADS // 2
DA_QBLOCK = 128
ROPE_THETA = 10000.0
FFN_HIDDEN = -(-8 * D_MODEL // (3 * 256)) * 256
NORM_EPS = 1e-6
SUBLN_EPS = 1e-5
LOG_FLOOR = 1e-30
IN_COLS = 5 * HG_WIDTH + 3 * DA_WIDTH
IN_SPLITS = tuple(HG_WIDTH * i for i in range(1, 6)) + tuple(5 * HG_WIDTH + DA_WIDTH * i for i in range(1, 3))

kernel_name = "hybrid_hgrn2_diffattn_encoder"


def _rms_norm(x, w, eps=NORM_EPS):
    xf = x.astype(jnp.float32)
    y = xf * lax.rsqrt(jnp.mean(xf * xf, axis=-1, keepdims=True) + eps)
    return (y * w.astype(jnp.float32)).astype(x.dtype)


def _rotary(x):
    T, dh = x.shape[1], x.shape[-1]
    inv = 1.0 / (ROPE_THETA ** (jnp.arange(0, dh, 2, dtype=jnp.float32) / dh))
    ang = jnp.arange(T, dtype=jnp.float32)[:, None] * inv[None, :]
    cos = jnp.cos(ang)[None, :, None, :]
    sin = jnp.sin(ang)[None, :, None, :]
    xf = x.astype(jnp.float32)
    x1, x2 = xf[..., : dh // 2], xf[..., dh // 2:]
    out = jnp.concatenate([x1 * cos - x2 * sin, x2 * cos + x1 * sin], axis=-1)
    return out.astype(x.dtype)


def _hgrn2_direction(q, k, v, log_f):
    B, T, H, DK = q.shape
    DV = v.shape[-1]
    n = T // HG_CHUNK

    def chunks(a):
        return a.reshape(B, n, HG_CHUNK, H, a.shape[-1]).transpose(1, 0, 3, 2, 4)

    causal = jnp.tril(jnp.ones((HG_CHUNK, HG_CHUNK), dtype=bool))[:, :, None]

    def step(state, inp):
        qc, kc, vc, gc = inp
        b = jnp.cumsum(gc, axis=2)
        diff = b[:, :, :, None, :] - b[:, :, None, :, :]
        decay = jnp.where(causal, jnp.exp(jnp.minimum(diff, 0.0)), 0.0)
        scores = jnp.einsum('bhtk,bhsk,bhtsk->bhts', qc, kc, decay)
        out = (jnp.einsum('bhts,bhsv->bhtv', scores, vc)
               + jnp.einsum('bhtk,bhkv->bhtv', qc * jnp.exp(b), state))
        b_end = b[:, :, -1:, :]
        state = (state * jnp.exp(b_end)[:, :, 0, :, None]
                 + jnp.einsum('bhsk,bhsv->bhkv', kc * jnp.exp(b_end - b), vc))
        return state, out

    s0 = jnp.zeros((B, H, DK, DV), jnp.float32)
    _, out = lax.scan(step, s0, (chunks(q), chunks(k), chunks(v), chunks(log_f)))
    return out.transpose(1, 0, 3, 2, 4).reshape(B, T, H, DV)


def _hgrn2_mixer(hq, hf_fwd, hf_bwd, hi, hg, lb, gnorm_w):
    B, T, _ = hq.shape
    shape_k = (B, T, HG_HEADS, HG_DK)
    q = jax.nn.silu(hq.astype(jnp.float32)).reshape(shape_k)
    v = hi.astype(jnp.float32).reshape(B, T, HG_HEADS, HG_DV)

    def gates(z, lb_dir):
        z = z.astype(jnp.float32).reshape(shape_k)
        lb_dir = lb_dir.reshape(HG_HEADS, HG_DK)
        log_f = jnp.logaddexp(jnp.log(jnp.maximum(lb_dir, LOG_FLOOR)),
                              jnp.log1p(-lb_dir) + jax.nn.log_sigmoid(z))
        k = (1.0 - lb_dir) * jax.nn.sigmoid(-z)
        return k, log_f

    k_f, lf_f = gates(hf_fwd, lb[0])
    k_b, lf_b = gates(hf_bwd, lb[1])
    flip = lambda a: jnp.flip(a, axis=1)
    o_f = _hgrn2_direction(q, k_f, v, lf_f)
    o_b = flip(_hgrn2_direction(flip(q), flip(k_b), flip(v), flip(lf_b)))
    gate = jax.nn.silu(hg.astype(jnp.float32)).reshape(B, T, HG_HEADS, HG_DV)
    o = _rms_norm(o_f + o_b, gnorm_w) * gate
    return o.reshape(B, T, HG_WIDTH).astype(hq.dtype)


def _diff_attention(hq, hk, hv, lq1, lk1, lq2, lk2, subln_w, lambda_init):
    B, T, _ = hq.shape
    q = _rotary(hq.reshape(B, T, 2 * DA_HEADS, DA_HEAD_DIM))
    k = _rotary(hk.reshape(B, T, 2 * DA_HEADS, DA_HEAD_DIM))
    v = hv.reshape(B, T, DA_HEADS, 2 * DA_HEAD_DIM)
    f32 = jnp.float32
    lam = (jnp.exp(jnp.sum(lq1.astype(f32) * lk1.astype(f32)))
           - jnp.exp(jnp.sum(lq2.astype(f32) * lk2.astype(f32))) + lambda_init)
    scale = DA_HEAD_DIM ** -0.5
    nq = T // DA_QBLOCK
    q_blocks = q.reshape(B, nq, DA_QBLOCK, 2 * DA_HEADS, DA_HEAD_DIM).transpose(1, 0, 2, 3, 4)

    def attend(qb):
        s = jnp.einsum('bqhd,bkhd->bhqk', qb, k).astype(f32) * scale
        p = jax.nn.softmax(s, axis=-1).reshape(B, DA_HEADS, 2, DA_QBLOCK, T)
        a = p[:, :, 0] - lam * p[:, :, 1]
        return jnp.einsum('bhqk,bkhv->bqhv', a.astype(v.dtype), v)

    o = lax.map(attend, q_blocks)
    o = o.transpose(1, 0, 2, 3, 4).reshape(B, T, DA_HEADS, 2 * DA_HEAD_DIM)
    o = _rms_norm(o, subln_w, SUBLN_EPS) * (1.0 - lambda_init)
    return o.reshape(B, T, DA_WIDTH)


def _layer(x, c, layer_idx, lb, w_ada, b_ada, norm_pre_mix, norm_post_mix, norm_pre_ffn,
           norm_post_ffn, w_in, hg_gnorm, lq1, lk1, lq2, lk2, da_subln, w_out,
           w_ffn_gate, w_ffn_up, w_ffn_down):
    mod = jax.nn.silu(c) @ w_ada + b_ada
    shift_m, scale_m, gate_m, shift_f, scale_f, gate_f = [m[:, None, :] for m in jnp.split(mod, 6, axis=-1)]
    h = _rms_norm(x, norm_pre_mix) * (1.0 + scale_m) + shift_m
    hq, hff, hfb, hi, hg, dq, dk, dv = jnp.split(h @ w_in, IN_SPLITS, axis=-1)
    o_hg = _hgrn2_mixer(hq, hff, hfb, hi, hg, lb, hg_gnorm)
    lambda_init = 0.8 - 0.6 * math.exp(-0.3 * layer_idx)
    o_da = _diff_attention(dq, dk, dv, lq1, lk1, lq2, lk2, da_subln, lambda_init)
    mix = jnp.concatenate([o_hg, o_da], axis=-1) @ w_out
    x = x + gate_m * _rms_norm(mix, norm_post_mix)
    h = _rms_norm(x, norm_pre_ffn) * (1.0 + scale_f) + shift_f
    ffn = (jax.nn.silu(h @ w_ffn_gate) * (h @ w_ffn_up)) @ w_ffn_down
    x = x + gate_f * _rms_norm(ffn, norm_post_ffn)
    return x


def setup_inputs(seed: int = 0) -> dict:
    key = jax.random.key(seed)
    ks = jax.random.split(key, 24)
    f32 = jnp.float32
    nrm = lambda k, shape, s: s * jax.random.normal(k, shape, f32)
    gain = lambda k, shape: 1.0 + 0.05 * jax.random.normal(k, shape, f32)
    return {
        "x_prompt": nrm(ks[0], (BATCH, SEQ, D_MODEL), 1.0),
        "x_sample": nrm(ks[1], (DEC_BATCH, DEC_SEQ, D_MODEL), 1.0),
        "c_prompt": nrm(ks[2], (BATCH, D_MODEL), 1.0),
        "c_sample": nrm(ks[3], (DEC_BATCH, D_MODEL), 1.0),
        "w_ada": nrm(ks[4], (DEPTH, D_MODEL, 6 * D_MODEL), 0.5 * D_MODEL ** -0.5),
        "b_ada": nrm(ks[5], (DEPTH, 6 * D_MODEL), 0.02),
        "norm_pre_mix": gain(ks[6], (DEPTH, D_MODEL)),
        "norm_post_mix": gain(ks[7], (DEPTH, D_MODEL)),
        "norm_pre_ffn": gain(ks[8], (DEPTH, D_MODEL)),
        "norm_post_ffn": gain(ks[9], (DEPTH, D_MODEL)),
        "w_in": nrm(ks[10], (DEPTH, D_MODEL, IN_COLS), D_MODEL ** -0.5),
        "hg_lower_bounds": 1.0 + 0.1 * jax.random.normal(ks[11], (2, DEPTH, HG_WIDTH), f32),
        "hg_gnorm": gain(ks[12], (DEPTH, HG_DV)),
        "da_lambda_q1": nrm(ks[13], (DEPTH, DA_HEAD_DIM), 0.1),
        "da_lambda_k1": nrm(ks[14], (DEPTH, DA_HEAD_DIM), 0.1),
        "da_lambda_q2": nrm(ks[15], (DEPTH, DA_HEAD_DIM), 0.1),
        "da_lambda_k2": nrm(ks[16], (DEPTH, DA_HEAD_DIM), 0.1),
        "da_subln": gain(ks[17], (DEPTH, 2 * DA_HEAD_DIM)),
        "w_out": nrm(ks[18], (DEPTH, MIX_WIDTH, D_MODEL), MIX_WIDTH ** -0.5),
        "w_ffn_gate": nrm(ks[19], (DEPTH, D_MODEL, FFN_HIDDEN), D_MODEL ** -0.5),
        "w_ffn_up": nrm(ks[20], (DEPTH, D_MODEL, FFN_HIDDEN), D_MODEL ** -0.5),
        "w_ffn_down": nrm(ks[21], (DEPTH, FFN_HIDDEN, D_MODEL), FFN_HIDDEN ** -0.5),
    }


def reference(x_prompt, x_sample, c_prompt, c_sample, w_ada, b_ada, norm_pre_mix, norm_post_mix,
              norm_pre_ffn, norm_post_ffn, w_in, hg_lower_bounds, hg_gnorm, da_lambda_q1,
              da_lambda_k1, da_lambda_q2, da_lambda_k2, da_subln, w_out, w_ffn_gate, w_ffn_up,
              w_ffn_down):
    lb_soft = jax.nn.softmax(hg_lower_bounds.astype(jnp.float32), axis=1)
    lb_all = jnp.cumsum(lb_soft, axis=1) - lb_soft[:, :1]

    def trunk(x, c):
        for l in range(DEPTH):
            x = _layer(x, c, l, lb_all[:, l], w_ada[l], b_ada[l], norm_pre_mix[l], norm_post_mix[l],
                       norm_pre_ffn[l], norm_post_ffn[l], w_in[l], hg_gnorm[l], da_lambda_q1[l],
                       da_lambda_k1[l], da_lambda_q2[l], da_lambda_k2[l], da_subln[l], w_out[l],
                       w_ffn_gate[l], w_ffn_up[l], w_ffn_down[l])
        return x

    y_prompt = trunk(x_prompt, c_prompt)
    y_sample = trunk(x_sample, c_sample)
    return (y_prompt, y_sample)
```

```cpp
#include <hip/hip_runtime.h>
#include <hip/hip_bf16.h>
#include <hip/hip_cooperative_groups.h>
#include <cstdio>
#include <cstdint>
namespace cg = cooperative_groups;

namespace pg8 {
#define PG8_LAS __attribute__((address_space(3)))
typedef unsigned short bf16_t;
typedef short bf16x8 __attribute__((ext_vector_type(8)));
typedef float f32x4 __attribute__((ext_vector_type(4)));
typedef unsigned u32x4 __attribute__((ext_vector_type(4)));
constexpr int BM = 256, BK = 64, HALF = 128, HTB = HALF * BK * 2  , STAGE_BYTES = 8 * HTB, NXCD = 8, WGM = 8;

__host__ __device__ __forceinline__ int lds_byte(int r, int c) { const int st = (r >> 4) * 2 + (c >> 5), rr = r & 15, cc = c & 31, ob = rr * 64 + cc * 2; return st * 1024 + (ob ^ (((ob >> 9) & 1) << 5)); }
__host__ __device__ __forceinline__ void stage_rc(int b, int& R, int& C) { const int st = b / 1024, sb = b % 1024, swz = sb ^ (((sb >> 9) & 1) << 5); R = (st >> 1) * 16 + swz / 64; C = (st & 1) * 32 + (swz % 64) / 2; }
__host__ __device__ __forceinline__ int perm32(int rho) { const int n = rho >> 4, i = rho & 15; return 8 * (i >> 2) + 4 * n + (i & 3); }

struct Unit { int pm, pn; };
struct Gemm { const bf16_t* A; const bf16_t* Bt; int M, N, K; };

struct StaticOrder {
    int nM, nN, nwg, G, c, rev;
    __host__ __device__ void init(int M, int N, int G_, int c_, int rev_ = 0) { nM = M / BM; nN = N / BM; nwg = nM * nN; G = G_; c = c_; rev = rev_; }
    __host__ __device__ bool next(int i, Unit& u) const {
        const long L = (long)i * G + c; if (L >= nwg) return false;
        int wgid = (int)L; { const int q = nwg / NXCD, r = nwg % NXCD, xcd = wgid % NXCD, off = wgid / NXCD; wgid = (xcd < r ? xcd * (q + 1) : r * (q + 1) + (xcd - r) * q) + off; }
        const int nig = WGM * nN, gid = wgid / nig, fm = gid * WGM, gsz = (nM - fm) < WGM ? (nM - fm) : WGM;
        u.pm = fm + ((wgid % nig) % gsz); u.pn = (wgid % nig) / gsz; if (rev) u.pm = nM - 1 - u.pm; return true;
    }
    __device__ __forceinline__ void a_ready(const Unit&) const {}
    __device__ __forceinline__ void done(const Unit&) const {}
};

typedef float f32x2_t __attribute__((ext_vector_type(2))); typedef __bf16 bf16x2_t __attribute__((ext_vector_type(2)));
__device__ __forceinline__ unsigned cvt_pk_bf16(float lo, float hi) { f32x2_t v = {lo, hi}; bf16x2_t b = __builtin_convertvector(v, bf16x2_t); return __builtin_bit_cast(unsigned, b); }
__device__ __forceinline__ float fast_rcp(float x) { return __builtin_amdgcn_rcpf(x); }
__device__ __forceinline__ float silu_f(float x) { return x * fast_rcp(1.0f + __builtin_amdgcn_exp2f(-1.4426950408889634f * x)); }
__device__ __forceinline__ float signeg_f(float x) { return fast_rcp(1.0f + __builtin_amdgcn_exp2f(1.4426950408889634f * x)); }
__device__ __forceinline__ u32x4 pack8(const f32x4& a, const f32x4& b) { u32x4 w; w.x = cvt_pk_bf16(a[0], a[1]); w.y = cvt_pk_bf16(a[2], a[3]); w.z = cvt_pk_bf16(b[0], b[1]); w.w = cvt_pk_bf16(b[2], b[3]); return w; }

struct EpiPlain {
    static constexpr bool PERM = true, AFTER_DRAIN = false;
    bf16_t* O; int ldc;
    __device__ __forceinline__ void operator()(const f32x4 (&acc)[2][2][4][2], const Unit& u, int wr, int wc, int fr, int fq) const {
        const int row0 = u.pm * BM + wr * 64 + fr, col0 = u.pn * BM + wc * 32 + 8 * fq;
#pragma unroll
        for (int ai = 0; ai < 2; ++ai)
#pragma unroll
            for (int m = 0; m < 4; ++m) { bf16_t* rowp = O + (size_t)(row0 + ai * HALF + m * 16) * ldc + col0;
#pragma unroll
                for (int bj = 0; bj < 2; ++bj) *(u32x4*)(rowp + bj * HALF) = pack8(acc[ai][bj][m][0], acc[ai][bj][m][1]); }
    }
};
struct EpiSwiGLU {
    static constexpr bool PERM = true, AFTER_DRAIN = false;
    bf16_t* O; int ldc;
    __device__ __forceinline__ void operator()(const f32x4 (&acc)[2][2][4][2], const Unit& u, int wr, int wc, int fr, int fq) const {
        const int row0 = u.pm * BM + wr * 64 + fr, col0 = u.pn * HALF + wc * 32 + 8 * fq;
#pragma unroll
        for (int ai = 0; ai < 2; ++ai)
#pragma unroll
            for (int m = 0; m < 4; ++m) { bf16_t* rowp = O + (size_t)(row0 + ai * HALF + m * 16) * ldc + col0;
                f32x4 h0, h1;
#pragma unroll
                for (int e = 0; e < 4; ++e) { h0[e] = silu_f(acc[ai][0][m][0][e]) * acc[ai][1][m][0][e]; h1[e] = silu_f(acc[ai][0][m][1][e]) * acc[ai][1][m][1][e]; }
                *(u32x4*)rowp = pack8(h0, h1); }
    }
};
struct EpiIn {
    static constexpr bool PERM = true, AFTER_DRAIN = false;
    bf16_t* O; int ldc; const float* cosT; const float* sinT; float qscale;
    __device__ __forceinline__ void operator()(const f32x4 (&acc)[2][2][4][2], const Unit& u, int wr, int wc, int fr, int fq) const {
        const int row0 = u.pm * BM + wr * 64 + fr; const int blk = u.pn >> 1;
        if (blk == 5 || blk == 6) {
            const float sc = (blk == 5) ? qscale : 1.0f; const int colh = u.pn * BM + 64 * wc + 8 * fq;
#pragma unroll
            for (int ai = 0; ai < 2; ++ai)
#pragma unroll
                for (int m = 0; m < 4; ++m) { const int row = row0 + ai * HALF + m * 16; const int t = row < 16384 ? (row & 4095) : (row & 2047);
                    bf16_t* rowp = O + (size_t)row * ldc + colh; f32x4 o1[2], o2[2];
#pragma unroll
                    for (int n = 0; n < 2; ++n) { const f32x4 c4 = *(const f32x4*)(cosT + t * 32 + 8 * fq + 4 * n), s4 = *(const f32x4*)(sinT + t * 32 + 8 * fq + 4 * n);
                        const f32x4 x1 = acc[ai][0][m][n], x2 = acc[ai][1][m][n];
                        o1[n] = (x1 * c4 - x2 * s4) * sc; o2[n] = (x2 * c4 + x1 * s4) * sc; }
                    *(u32x4*)rowp = pack8(o1[0], o1[1]); *(u32x4*)(rowp + 32) = pack8(o2[0], o2[1]); }
        } else {
            const int act = (blk == 0) ? 1 : ((blk == 1 || blk == 2) ? 2 : 0);     const int col0 = u.pn * BM + wc * 32 + 8 * fq;
#pragma unroll
            for (int ai = 0; ai < 2; ++ai)
#pragma unroll
                for (int m = 0; m < 4; ++m) { bf16_t* rowp = O + (size_t)(row0 + ai * HALF + m * 16) * ldc + col0;
#pragma unroll
                    for (int bj = 0; bj < 2; ++bj) { f32x4 v0 = acc[ai][bj][m][0], v1 = acc[ai][bj][m][1];
                        if (act == 1) {
#pragma unroll
                            for (int e = 0; e < 4; ++e) { v0[e] = silu_f(v0[e]); v1[e] = silu_f(v1[e]); } }
                        else if (act == 2) {
#pragma unroll
                            for (int e = 0; e < 4; ++e) { v0[e] = signeg_f(v0[e]); v1[e] = signeg_f(v1[e]); } }
                        *(u32x4*)(rowp + bj * HALF) = pack8(v0, v1); } }
        }
    }
};

template <class Epi, class Sched, bool ALIGN_EPI = false, bool SP2 = false>
__device__ __forceinline__ void gemm_phase(PG8_LAS unsigned char* lds, const Gemm g, const Sched& S, const Epi& E) {
    int tid_l = threadIdx.x; asm volatile("" : "+v"(tid_l));
    const int tid = tid_l, wid = __builtin_amdgcn_readfirstlane(tid >> 6), lane = tid & 63, wr = wid >> 2, wc = wid & 3, fr = lane & 15, fq = lane >> 4;
    const int K = g.K, nt = K / BK;
    unsigned voffA[2], voffB[2];
#pragma unroll
    for (int i = 0; i < 2; ++i) { int R, C; stage_rc(tid * 16 + i * 8192, R, C); const int Rb = Epi::PERM ? ((R & ~31) + perm32(R & 31)) : R;
        voffA[i] = (unsigned)(R * K + C) * 2u; voffB[i] = (unsigned)(Rb * K + C) * 2u; }
    const size_t kstep = (size_t)(BK * 2);
    const size_t hstep = (size_t)HALF * K * 2;
    const size_t tstep = 2 * hstep;
    const unsigned ldsw = (unsigned)wid * 1024u;
    const int aoff = lds_byte(wr * 64 + fr, fq * 8), boff = lds_byte(wc * 32 + fr, fq * 8);
#define PG8_SA(b, h) (((b) * 2 + (h)) * HTB)
#define PG8_SB(b, h) ((4 + (b) * 2 + (h)) * HTB)
#define PG8_STAGE(bufoff, gbase, voff) do { _Pragma("unroll") for (int _i = 0; _i < 2; ++_i) \
        __builtin_amdgcn_global_load_lds((const unsigned*)((const char*)(gbase) + (voff)[_i]), (PG8_LAS unsigned*)(lds + (bufoff) + ldsw + _i * 8192), 16, 0, 0); } while (0)
#define PG8_LDA(dst, b, h) do { _Pragma("unroll") for (int m = 0; m < 4; ++m) _Pragma("unroll") for (int k = 0; k < 2; ++k) dst[m][k] = *(const PG8_LAS bf16x8*)(lds + PG8_SA(b, h) + aoff + m * 2048 + k * 1024); } while (0)
#define PG8_LDB(dst, b, h) do { _Pragma("unroll") for (int n = 0; n < 2; ++n) _Pragma("unroll") for (int k = 0; k < 2; ++k) dst[n][k] = *(const PG8_LAS bf16x8*)(lds + PG8_SB(b, h) + boff + n * 2048 + k * 1024); } while (0)
#define PG8_MMA(ai, bj, At, Bt) do { __builtin_amdgcn_s_setprio(1); _Pragma("unroll") for (int m = 0; m < 4; ++m) _Pragma("unroll") for (int n = 0; n < 2; ++n) _Pragma("unroll") for (int k = 0; k < 2; ++k) \
        acc[ai][bj][m][n] = __builtin_amdgcn_mfma_f32_16x16x32_bf16(Bt[n][k], At[m][k], acc[ai][bj][m][n], 0, 0, 0); __builtin_amdgcn_s_setprio(0); } while (0)
#define PG8_WAIT_V(n) asm volatile("s_waitcnt vmcnt(" #n ")" ::: "memory")
#define PG8_WAIT_L(n) asm volatile("s_waitcnt lgkmcnt(" #n ")" ::: "memory")
#define PG8_BAR __builtin_amdgcn_s_barrier()
#define PG8_SCHED __builtin_amdgcn_sched_barrier(0)
    Unit cur, nxt; int ui = 0;
    if (!S.next(0, cur)) return;
    f32x4 acc[2][2][4][2];
#pragma unroll
    for (int a = 0; a < 2; ++a)
#pragma unroll
        for (int b = 0; b < 2; ++b)
#pragma unroll
            for (int m = 0; m < 4; ++m)
#pragma unroll
                for (int n = 0; n < 2; ++n) acc[a][b][m][n] = (f32x4){0.f, 0.f, 0.f, 0.f};
    bf16x8 At[4][2], B0[2][2], B1[2][2];
    const char* cA = (const char*)g.A + (size_t)cur.pm * tstep; const char* cB = (const char*)g.Bt + (size_t)cur.pn * tstep;
    S.a_ready(cur);
    if constexpr (SP2) {
        PG8_STAGE(PG8_SB(0, 0), cB, voffB); PG8_STAGE(PG8_SB(0, 1), cB + hstep, voffB); PG8_STAGE(PG8_SA(0, 0), cA, voffA); PG8_STAGE(PG8_SA(0, 1), cA + hstep, voffA);
        if (wr == 1) PG8_BAR;
        PG8_WAIT_V(2); PG8_BAR;
        PG8_STAGE(PG8_SB(1, 0), cB + kstep, voffB); PG8_STAGE(PG8_SA(1, 0), cA + kstep, voffA); PG8_STAGE(PG8_SB(1, 1), cB + hstep + kstep, voffB);
        PG8_WAIT_V(6); PG8_BAR;
    } else {
        PG8_STAGE(PG8_SB(0, 0), cB, voffB); PG8_STAGE(PG8_SA(0, 0), cA, voffA); PG8_STAGE(PG8_SB(0, 1), cB + hstep, voffB); PG8_STAGE(PG8_SA(0, 1), cA + hstep, voffA);
        if (wr == 1) PG8_BAR;
        PG8_WAIT_V(4); PG8_BAR;
        PG8_STAGE(PG8_SB(1, 0), cB + kstep, voffB); PG8_STAGE(PG8_SA(1, 0), cA + kstep, voffA); PG8_STAGE(PG8_SB(1, 1), cB + hstep + kstep, voffB);
        PG8_WAIT_V(6); PG8_BAR;
    }
    for (;;) {
        const bool has_next = S.next(ui + 1, nxt);
        const char* nA = has_next ? (const char*)g.A + (size_t)nxt.pm * tstep : cA; const char* nB = has_next ? (const char*)g.Bt + (size_t)nxt.pn * tstep : cB;
        for (int t = 0; t < nt; t += 2) {
            const bool last = (t == nt - 2);
            const char* a1 = cA + (size_t)(t + 1) * kstep;
            const char* a2 = last ? nA : cA + (size_t)(t + 2) * kstep; const char* b2 = last ? nB : cB + (size_t)(t + 2) * kstep;
            const char* a3 = a2 + kstep; const char* b3 = b2 + kstep;
            if (last && has_next) S.a_ready(nxt);
            if constexpr (SP2) {
            PG8_LDB(B0, 0, 0); PG8_LDB(B1, 0, 1); PG8_SCHED; PG8_LDA(At, 0, 0); PG8_STAGE(PG8_SA(1, 1), a1 + hstep, voffA);
            PG8_WAIT_V(8); PG8_WAIT_L(0); PG8_BAR; PG8_MMA(0, 0, At, B0); PG8_MMA(0, 1, At, B1); PG8_BAR; PG8_SCHED;
            PG8_LDA(At, 0, 1); PG8_STAGE(PG8_SB(0, 0), b2, voffB); PG8_STAGE(PG8_SB(0, 1), b2 + hstep, voffB); PG8_STAGE(PG8_SA(0, 0), a2, voffA);
            PG8_WAIT_V(8); PG8_WAIT_L(0); PG8_BAR; PG8_MMA(1, 0, At, B0); PG8_MMA(1, 1, At, B1); PG8_BAR; PG8_SCHED;
            PG8_LDB(B0, 1, 0); PG8_LDB(B1, 1, 1); PG8_SCHED; PG8_LDA(At, 1, 0); PG8_STAGE(PG8_SA(0, 1), a2 + hstep, voffA);
            PG8_WAIT_V(8); PG8_WAIT_L(0); PG8_BAR; PG8_MMA(0, 0, At, B0); PG8_MMA(0, 1, At, B1); PG8_BAR; PG8_SCHED;
            PG8_LDA(At, 1, 1); PG8_STAGE(PG8_SB(1, 0), b3, voffB); PG8_STAGE(PG8_SB(1, 1), b3 + hstep, voffB); PG8_STAGE(PG8_SA(1, 0), a3, voffA);
            PG8_WAIT_V(8); PG8_WAIT_L(0); PG8_BAR; PG8_MMA(1, 0, At, B0); PG8_MMA(1, 1, At, B1); PG8_BAR; PG8_SCHED;
            } else {
            PG8_LDB(B0, 0, 0); PG8_SCHED; PG8_LDA(At, 0, 0); PG8_STAGE(PG8_SA(1, 1), a1 + hstep, voffA);
            PG8_WAIT_L(8); PG8_BAR; PG8_WAIT_L(0); PG8_MMA(0, 0, At, B0); PG8_BAR; PG8_SCHED;
            PG8_LDB(B1, 0, 1); PG8_STAGE(PG8_SB(0, 0), b2, voffB);
            PG8_BAR; PG8_WAIT_L(0); PG8_MMA(0, 1, At, B1); PG8_BAR;
            PG8_LDA(At, 0, 1); PG8_STAGE(PG8_SA(0, 0), a2, voffA);
            PG8_BAR; PG8_WAIT_L(0); PG8_MMA(1, 0, At, B0); PG8_BAR; PG8_SCHED;
            PG8_STAGE(PG8_SB(0, 1), b2 + hstep, voffB);
            PG8_WAIT_V(6); PG8_BAR; PG8_MMA(1, 1, At, B1); PG8_BAR;
            PG8_LDB(B0, 1, 0); PG8_SCHED; PG8_LDA(At, 1, 0); PG8_STAGE(PG8_SA(0, 1), a2 + hstep, voffA);
            PG8_WAIT_L(8); PG8_BAR; PG8_WAIT_L(0); PG8_MMA(0, 0, At, B0); PG8_BAR; PG8_SCHED;
            PG8_LDB(B1, 1, 1); PG8_STAGE(PG8_SB(1, 0), b3, voffB);
            PG8_BAR; PG8_WAIT_L(0); PG8_MMA(0, 1, At, B1); PG8_BAR;
            PG8_LDA(At, 1, 1); PG8_STAGE(PG8_SA(1, 0), a3, voffA);
            PG8_BAR; PG8_WAIT_L(0); PG8_MMA(1, 0, At, B0); PG8_BAR; PG8_SCHED;
            PG8_STAGE(PG8_SB(1, 1), b3 + hstep, voffB);
            PG8_WAIT_V(6); PG8_BAR; PG8_MMA(1, 1, At, B1); PG8_BAR;
            }
        }
        if constexpr (ALIGN_EPI) { if (wr == 0) PG8_BAR; }
        if constexpr (!Epi::AFTER_DRAIN) { E(acc, cur, wr, wc, fr, fq); S.done(cur); }
        if (!has_next) break;
#pragma unroll
        for (int a = 0; a < 2; ++a)
#pragma unroll
            for (int b = 0; b < 2; ++b)
#pragma unroll
                for (int m = 0; m < 4; ++m)
#pragma unroll
                    for (int n = 0; n < 2; ++n) acc[a][b][m][n] = (f32x4){0.f, 0.f, 0.f, 0.f};
        cur = nxt; cA = nA; cB = nB; ++ui;
        if constexpr (ALIGN_EPI) { if (wr == 1) PG8_BAR; }
    }
    PG8_WAIT_V(0);
    if constexpr (!ALIGN_EPI) { if (wr == 0) PG8_BAR; }
    PG8_BAR;
    if constexpr (Epi::AFTER_DRAIN) { E.fused(acc, cur, wr, wc, fr, fq, lds, wid, lane); S.done(cur); }
#undef PG8_SA
#undef PG8_SB
#undef PG8_STAGE
#undef PG8_LDA
#undef PG8_LDB
#undef PG8_MMA
#undef PG8_WAIT_V
#undef PG8_WAIT_L
#undef PG8_BAR
#undef PG8_SCHED
}
}
namespace att {
using bf16x8 = __attribute__((ext_vector_type(8))) short;
using s16x4  = __attribute__((ext_vector_type(4))) short;
using f32x16 = __attribute__((ext_vector_type(16))) float;
using u32x4  = __attribute__((ext_vector_type(4))) unsigned;
constexpr int NW = 8, QBLK = 32, KVBLK = 64, LD = 4096;
constexpr float THRL = 11.5f;
constexpr int SHM_V = KVBLK * 128 * 2, SHM_K = KVBLK * 128 * 2, SHM_ATTN = 2 * SHM_V + 2 * SHM_K + NW * 64 * 4;
#define KSWZ(row, colB) ((row) * 256 + ((colB) ^ (((row) & 7) << 4)))
#define SBAR() __builtin_amdgcn_sched_barrier(0)
__device__ __forceinline__ int crow(int r, int hi) { return (r & 3) + 8 * (r >> 2) + 4 * hi; }
__device__ __forceinline__ unsigned cvtpk(float lo, float hi) { return pg8::cvt_pk_bf16(lo, hi); }

__device__ __forceinline__ void partialSM(f32x16& p0, f32x16& p1, float& m_reg, float& mn, float& alpha) {
  float pmax = p0[0];
#pragma unroll
  for (int r = 1; r < 16; ++r) pmax = fmaxf(pmax, p0[r]);
#pragma unroll
  for (int r = 0; r < 16; ++r) pmax = fmaxf(pmax, p1[r]);
  { auto rr = __builtin_amdgcn_permlane32_swap(__float_as_uint(pmax), __float_as_uint(pmax), false, false);
    pmax = fmaxf(__uint_as_float(rr[0]), __uint_as_float(rr[1])); }
  if (__builtin_expect(__all(pmax - m_reg <= THRL), 1)) { mn = m_reg; alpha = 1.f; }
  else { mn = fmaxf(m_reg, pmax); alpha = __builtin_amdgcn_exp2f(m_reg - mn); m_reg = mn; }
#pragma unroll
  for (int r = 0; r < 16; ++r) p0[r] = p0[r] - mn;
#pragma unroll
  for (int r = 0; r < 16; ++r) p1[r] = p1[r] - mn;
#pragma unroll
  for (int r = 0; r < 16; ++r) p0[r] = __builtin_amdgcn_exp2f(p0[r]);
}
__device__ __forceinline__ void finishSM(f32x16& p0, f32x16& p1, float alpha, float& l_reg, bf16x8& pa0, bf16x8& pa1, bf16x8& pa2, bf16x8& pa3) {
#pragma unroll
  for (int r = 0; r < 16; ++r) p1[r] = __builtin_amdgcn_exp2f(p1[r]);
  float ps = 0;
#pragma unroll
  for (int r = 0; r < 16; ++r) ps += p0[r];
#pragma unroll
  for (int r = 0; r < 16; ++r) ps += p1[r];
  { auto rr = __builtin_amdgcn_permlane32_swap(__float_as_uint(ps), __float_as_uint(ps), false, false);
    ps = __uint_as_float(rr[0]) + __uint_as_float(rr[1]); }
  l_reg = l_reg * alpha + ps;
#define PK4(P, BASE, OUT) do { unsigned a0 = cvtpk(P[BASE + 0], P[BASE + 1]), a1 = cvtpk(P[BASE + 2], P[BASE + 3]);   \
    unsigned b0 = cvtpk(P[BASE + 4], P[BASE + 5]), b1 = cvtpk(P[BASE + 6], P[BASE + 7]);                              \
    auto r0 = __builtin_amdgcn_permlane32_swap(a0, b0, false, false); auto r1 = __builtin_amdgcn_permlane32_swap(a1, b1, false, false); \
    u32x4 w = {r0[0], r1[0], r0[1], r1[1]}; OUT = *reinterpret_cast<bf16x8*>(&w); } while (0)
  PK4(p0, 0, pa0); PK4(p0, 8, pa1); PK4(p1, 0, pa2); PK4(p1, 8, pa3);
#undef PK4
}
__device__ __forceinline__ void qkt(f32x16& p0, f32x16& p1, const char* Ks, const bf16x8* qr, int r32, int hi, int sub) {
  p0 = f32x16{}; p1 = f32x16{};
#pragma unroll
  for (int d0 = 0; d0 < 4; ++d0) { int cb = ((sub * 4 + d0) * 16 + hi * 8) * 2;
    bf16x8 b0 = *reinterpret_cast<const bf16x8*>(Ks + KSWZ(r32, cb));
    bf16x8 b1 = *reinterpret_cast<const bf16x8*>(Ks + KSWZ(32 + r32, cb));
    p0 = __builtin_amdgcn_mfma_f32_32x32x16_bf16(b0, qr[d0], p0, 0, 0, 0);
    p1 = __builtin_amdgcn_mfma_f32_32x32x16_bf16(b1, qr[d0], p1, 0, 0, 0); }
}
__device__ __forceinline__ int v_st(int k, int c) { const int kk = (k & ~0xC) | ((k & 4) << 1) | ((k & 8) >> 1); return ((kk >> 3) * 4 + (c >> 5)) * 512 + ((kk & 7) * 32 + (c & 31)) * 2; }
__device__ __forceinline__ int v_rd_base(int lane) { return ((lane & 3) << 3) | (((lane >> 2) & 3) << 6) | (((lane >> 4) & 1) << 5) | (((lane >> 5) & 1) << 8); }
constexpr int v_rd_off(int d0, int ks, int half) { return d0 * 512 + ks * 4096 + half * 2048; }
template <int OFF> __device__ __forceinline__ s16x4 tr_read(int vb) {
  s16x4 r; asm volatile("ds_read_b64_tr_b16 %0, %1 offset:%2" : "=&v"(r) : "v"(vb), "i"(OFF) : "memory"); return r;
}
template <int D0> __device__ __forceinline__ void pv_one(f32x16& od, int vb, bf16x8 pa0, bf16x8 pa1, bf16x8 pa2, bf16x8 pa3) {
  const s16x4 l0 = tr_read<v_rd_off(D0, 0, 0)>(vb), h0 = tr_read<v_rd_off(D0, 0, 1)>(vb), l1 = tr_read<v_rd_off(D0, 1, 0)>(vb), h1 = tr_read<v_rd_off(D0, 1, 1)>(vb);
  const s16x4 l2 = tr_read<v_rd_off(D0, 2, 0)>(vb), h2 = tr_read<v_rd_off(D0, 2, 1)>(vb), l3 = tr_read<v_rd_off(D0, 3, 0)>(vb), h3 = tr_read<v_rd_off(D0, 3, 1)>(vb);
  asm volatile("s_waitcnt lgkmcnt(0)" ::: "memory"); SBAR();
#define PK(L, H) (bf16x8){L[0], L[1], L[2], L[3], H[0], H[1], H[2], H[3]}
  od = __builtin_amdgcn_mfma_f32_32x32x16_bf16(pa0, PK(l0, h0), od, 0, 0, 0);
  od = __builtin_amdgcn_mfma_f32_32x32x16_bf16(pa1, PK(l1, h1), od, 0, 0, 0);
  od = __builtin_amdgcn_mfma_f32_32x32x16_bf16(pa2, PK(l2, h2), od, 0, 0, 0);
  od = __builtin_amdgcn_mfma_f32_32x32x16_bf16(pa3, PK(l3, h3), od, 0, 0, 0);
#undef PK
}
__device__ __forceinline__ void pv_d0(f32x16* o, int vb, bf16x8 pa0, bf16x8 pa1, bf16x8 pa2, bf16x8 pa3) {
  pv_one<0>(o[0], vb, pa0, pa1, pa2, pa3); pv_one<1>(o[1], vb, pa0, pa1, pa2, pa3); pv_one<2>(o[2], vb, pa0, pa1, pa2, pa3); pv_one<3>(o[3], vb, pa0, pa1, pa2, pa3);
}

__device__ __forceinline__ void attn_unit(const unsigned short* __restrict__ Qb, const unsigned short* __restrict__ Kh, const unsigned short* __restrict__ Vh,
                                          unsigned short* __restrict__ Ob, int seq, char* lds, float lam, float post, const float* __restrict__ subln) {
  int tid_l = threadIdx.x; asm volatile("" : "+v"(tid_l));
  const int tid = tid_l, wid = tid >> 6, lane = tid & 63, r32 = lane & 31, hi = lane >> 5;
  const int sub = __builtin_amdgcn_readfirstlane(wid >> 2), wq = __builtin_amdgcn_readfirstlane(wid & 3);
  char* V_lds = lds; char* K_lds = lds + 2 * SHM_V;
  float* ws = (float*)(lds + 2 * SHM_V + 2 * SHM_K) + wid * 64; float* li_l = ws; float* al_l = ws + 32;
  float m_reg = -1e30f, l_reg = 0; f32x16 o[4] = {}; bf16x8 qr[4];
  const unsigned short* Qw = Qb + (long)(wq * QBLK + r32) * LD + sub * 64 + hi * 8;
#pragma unroll
  for (int d0 = 0; d0 < 4; ++d0) qr[d0] = *reinterpret_cast<const bf16x8*>(Qw + d0 * 16);
  const int sr = tid >> 4, sc = (tid & 15) * 8, vst0 = v_st(sr, sc), vst1 = v_st(32 + sr, sc);
  const int vb0 = (int)(uintptr_t)V_lds + v_rd_base(lane);
  struct { bf16x8 vs0, vs1, ks0, ks1; } sr_[2];
#define SLOAD(i, k0) do { sr_[i].vs0 = *reinterpret_cast<const bf16x8*>(&Vh[(long)((k0) + sr) * LD + sc]); sr_[i].vs1 = *reinterpret_cast<const bf16x8*>(&Vh[(long)((k0) + 32 + sr) * LD + sc]); \
    sr_[i].ks0 = *reinterpret_cast<const bf16x8*>(&Kh[(long)((k0) + sr) * LD + sc]); sr_[i].ks1 = *reinterpret_cast<const bf16x8*>(&Kh[(long)((k0) + 32 + sr) * LD + sc]); } while (0)
#define SWRITE(b, i) do { *(bf16x8*)(V_lds + (b) * SHM_V + vst0) = sr_[i].vs0;          \
    *(bf16x8*)(V_lds + (b) * SHM_V + vst1) = sr_[i].vs1; int kc = sc * 2;               \
    *(bf16x8*)(K_lds + (b) * SHM_K + KSWZ(sr, kc)) = sr_[i].ks0;                       \
    *(bf16x8*)(K_lds + (b) * SHM_K + KSWZ(32 + sr, kc)) = sr_[i].ks1; } while (0)
#define SWAIT() asm volatile("s_waitcnt vmcnt(4)" ::: "memory")
#define RESC(a) do { if (__any((a) < 1.f)) { if (hi == 0) al_l[r32] = (a); asm volatile("s_waitcnt lgkmcnt(0)" ::: "memory"); \
    _Pragma("unroll") for (int d = 0; d < 4; ++d) _Pragma("unroll") for (int r = 0; r < 16; ++r) o[d][r] *= al_l[crow(r, hi)]; } } while (0)
  f32x16 pA0, pA1, pB0, pB1; float mnA, mnB, alA, alB; bf16x8 pa0, pa1, pa2, pa3; const int NT = seq / KVBLK;
  constexpr int SE = 0, SO = 1;
  SLOAD(SE, 0); asm volatile("s_waitcnt vmcnt(0)" ::: "memory"); SWRITE(0, SE); __syncthreads();
  qkt(pA0, pA1, K_lds, qr, r32, hi, sub); partialSM(pA0, pA1, m_reg, mnA, alA);
  SLOAD(SO, KVBLK); if (2 < NT) SLOAD(SE, 2 * KVBLK);
  SWAIT(); SWRITE(1, SO); __syncthreads();
  for (int j = 1; j + 1 < NT; j += 2) {
    SBAR(); qkt(pB0, pB1, K_lds + SHM_K, qr, r32, hi, sub);
    finishSM(pA0, pA1, alA, l_reg, pa0, pa1, pa2, pa3); SBAR();
    SLOAD(SO, (j + 2) * KVBLK); SBAR();
    pv_d0(o, vb0, pa0, pa1, pa2, pa3); partialSM(pB0, pB1, m_reg, mnB, alB);
    __syncthreads(); SWAIT(); SWRITE(0, SE);
    RESC(alB); __syncthreads();
    SBAR(); qkt(pA0, pA1, K_lds, qr, r32, hi, sub);
    finishSM(pB0, pB1, alB, l_reg, pa0, pa1, pa2, pa3); SBAR();
    if (j + 3 < NT) SLOAD(SE, (j + 3) * KVBLK); SBAR();
    pv_d0(o, vb0 + (int)SHM_V, pa0, pa1, pa2, pa3); partialSM(pA0, pA1, m_reg, mnA, alA);
    __syncthreads(); SWAIT(); SWRITE(1, SO);
    RESC(alA); __syncthreads();
  }
  SBAR(); qkt(pB0, pB1, K_lds + SHM_K, qr, r32, hi, sub);
  finishSM(pA0, pA1, alA, l_reg, pa0, pa1, pa2, pa3); SBAR();
  pv_d0(o, vb0, pa0, pa1, pa2, pa3); partialSM(pB0, pB1, m_reg, mnB, alB);
  __syncthreads(); RESC(alB);
  finishSM(pB0, pB1, alB, l_reg, pa0, pa1, pa2, pa3); SBAR();
  pv_d0(o, vb0 + (int)SHM_V, pa0, pa1, pa2, pa3);
  if (hi == 0) li_l[r32] = l_reg; asm volatile("s_waitcnt lgkmcnt(0)" ::: "memory");
  float rli[16];
#pragma unroll
  for (int r = 0; r < 16; ++r) rli[r] = __builtin_amdgcn_rcpf(li_l[crow(r, hi)]);
  asm volatile("s_waitcnt vmcnt(0)" ::: "memory");
  __syncthreads();
  float* X = (float*)lds;
  if (sub == 1) {
#pragma unroll
    for (int r = 0; r < 16; ++r) { const int orow = crow(r, hi);
#pragma unroll
      for (int d0 = 0; d0 < 4; ++d0) X[(wq * 32 + orow) * 128 + d0 * 32 + r32] = o[d0][r] * rli[r]; }
  }
  __syncthreads();
  if (sub == 0) {
    float sw[4];
#pragma unroll
    for (int d0 = 0; d0 < 4; ++d0) sw[d0] = subln[d0 * 32 + r32] * post;
    unsigned short* Ow = Ob + (long)(wq * QBLK) * 1024;
#pragma unroll
    for (int r = 0; r < 16; ++r) { const int orow = crow(r, hi); float ss = 0.f; float v[4];
#pragma unroll
      for (int d0 = 0; d0 < 4; ++d0) { v[d0] = o[d0][r] * rli[r] - lam * X[(wq * 32 + orow) * 128 + d0 * 32 + r32]; ss += v[d0] * v[d0]; }
      ss += __shfl_xor(ss, 1); ss += __shfl_xor(ss, 2); ss += __shfl_xor(ss, 4); ss += __shfl_xor(ss, 8); ss += __shfl_xor(ss, 16);
      const float rs = __builtin_amdgcn_rsqf(ss * (1.0f / 128.0f) + 1e-5f);
#pragma unroll
      for (int d0 = 0; d0 < 4; ++d0) { const float ov = v[d0] * rs * sw[d0]; Ow[(long)orow * 1024 + d0 * 32 + r32] = (unsigned short)(cvtpk(ov, ov) & 0xffffu); } }
  }
  __syncthreads();
#undef SLOAD
#undef SWRITE
#undef SWAIT
#undef RESC
}
#undef SBAR
#undef KSWZ
}

constexpr int DM = 1024, MTOK = 49152, NPROMPT = 16384, TP = 4096, TS = 2048, NCB = 20, FFH = 2816, INC = 4096;
constexpr size_t MiB = 1u << 20;
constexpr size_t WS_WIN = 0, WS_WOUT = 8 * MiB, WS_W1 = 10 * MiB, WS_W2 = 21 * MiB;
constexpr size_t WS_MOD = 27 * MiB;
constexpr size_t WS_CTR = 27 * MiB + 983040;
constexpr size_t WS_BAR = 27 * MiB + 983040 + 4096;
constexpr size_t WS_COS = 28 * MiB, WS_SIN = 28 * MiB + 512 * 1024;
constexpr size_t WS_BUFA = 29 * MiB;
constexpr size_t WS_QKV = 125 * MiB;
constexpr size_t WS_Y = WS_QKV + 264 * MiB;
constexpr size_t WS_END = WS_QKV + 384 * MiB;
constexpr int C_Q = 0, C_UF = 512, C_UB = 1024, C_V = 1536, C_G = 2048, C_DQ = 2560, C_DK = 3072, C_DV = 3584;

typedef unsigned short bf16;
typedef unsigned v4u __attribute__((ext_vector_type(4)));
typedef unsigned v2u __attribute__((ext_vector_type(2)));
typedef float f32x4 __attribute__((ext_vector_type(4)));
typedef short bf16x8 __attribute__((ext_vector_type(8)));
typedef short bf16x4 __attribute__((ext_vector_type(4)));
#define LAS __attribute__((address_space(3)))
__device__ __forceinline__ unsigned pk2(float lo, float hi) { return pg8::cvt_pk_bf16(lo, hi); }
__device__ __forceinline__ float bf2f(unsigned short h) { return __uint_as_float((unsigned)h << 16); }
__device__ __forceinline__ float bflo(unsigned w) { return __uint_as_float(w << 16); }
__device__ __forceinline__ float bfhi(unsigned w) { return __uint_as_float(w & 0xffff0000u); }
__device__ __forceinline__ float wave_sum(float v) {
#pragma unroll
    for (int o = 1; o < 64; o <<= 1) v += __shfl_xor(v, o);
    return v;
}

struct Args { const float* in[22]; float* out; unsigned char* ws; int ph_lo, ph_hi; };

namespace hg {
constexpr int RS = 272;
constexpr int OFF_QT = 0, OFF_KD = 32 * RS, OFF_KET = 2 * 32 * RS, OFF_VT = OFF_KET + 128 * 64, OFF_D = OFF_VT + 128 * 64, BUF = OFF_D + 512;
__device__ __forceinline__ void chain(const Args& a, int layer, int cid, char* lds) {
    int tid_l = threadIdx.x; asm volatile("" : "+v"(tid_l));
    const int tid = tid_l, lane = tid & 63, w = __builtin_amdgcn_readfirstlane(tid >> 6), kc = lane & 15, tg = lane >> 4;
    int cb, hd, dir, T, row0;
    if (cid < 32) { cb = cid >> 3; hd = (cid >> 1) & 3; dir = cid & 1; T = TP; row0 = cb * TP; }
    else { const int c2 = cid - 32; cb = 4 + (c2 >> 3); hd = (c2 >> 1) & 3; dir = c2 & 1; T = TS; row0 = NPROMPT + (cb - 4) * TS; }
    const int k = 16 * w + kc;
    float lb = 0.f;
    if (layer == 1) { const float a0 = a.in[11][(dir * 2 + 0) * 512 + 128 * hd + k], a1 = a.in[11][(dir * 2 + 1) * 512 + 128 * hd + k]; lb = 1.0f / (1.0f + __expf(a0 - a1)); }
    const float lbf = fmaxf(lb, 1e-30f), oml = 1.0f - lb;
    bf16* QKV = (bf16*)(a.ws + WS_QKV);
    const bf16* qp = QKV + C_Q + 128 * hd; const bf16* up = QKV + C_UF + 512 * dir + 128 * hd; const bf16* vp = QKV + C_V + 128 * hd;
    bf16* op = QKV + C_UF + 512 * dir + 128 * hd;
    const int c = lane & 15, g = lane >> 4;
    unsigned toff[8], ooff[8];
#pragma unroll
    for (int j = 0; j < 8; ++j) { const int tau = 8 * tg + j; toff[j] = (unsigned)((dir ? 31 - tau : tau) * INC + k);
        const int to = 16 * (j >> 2) + 4 * g + (j & 3); ooff[j] = (unsigned)((dir ? 31 - to : to) * INC + 16 * w + c); }
    const int NS = T / 32;
    unsigned rq[2][8], ru[2][8], rv[2][8];
#define HG_RB(i) ((size_t)(row0 + (dir ? (T - 32 - 32 * (i)) : 32 * (i))) * INC)
#define HG_LOAD(s_, i) do { const bf16* q_ = qp + HG_RB(i); const bf16* u_ = up + HG_RB(i); const bf16* v_ = vp + HG_RB(i); _Pragma("unroll") for (int j = 0; j < 8; ++j) { rq[s_][j] = q_[toff[j]]; ru[s_][j] = u_[toff[j]]; rv[s_][j] = v_[toff[j]]; } } while (0)
#define HG_PREP(s_, bufp) do { char* B_ = (bufp); float kk[8], pl[8]; \
          \
        _Pragma("unroll") for (int j = 0; j < 8; ++j) { asm volatile("" : "+v"(rq[s_][j]), "+v"(ru[s_][j]), "+v"(rv[s_][j])); } \
        _Pragma("unroll") for (int j = 0; j < 8; ++j) { const float uu = __uint_as_float(ru[s_][j] << 16); kk[j] = oml * uu; const float f = fmaxf(lbf + (oml - kk[j]), 9.765625e-4f); pl[j] = (j == 0) ? f : pl[j - 1] * f; } \
        const float G = pl[7]; float s1 = __shfl_up(G, 16); if (tg < 1) s1 = 1.f; const float i2 = G * s1; float s2 = __shfl_up(i2, 32); if (tg < 2) s2 = 1.f; const float incl = i2 * s2; \
        float E = __shfl_up(incl, 16); if (tg == 0) E = 1.f; const float Pend = __shfl(incl, 48 + kc); float ke[8]; \
        _Pragma("unroll") for (int j = 0; j < 8; ++j) { const float P = fmaxf(E * pl[j], 1e-30f); const float rP = __builtin_amdgcn_rcpf(P); const float qt = __uint_as_float(rq[s_][j] << 16) * P; const float kd = kk[j] * rP; ke[j] = kd * Pend; \
            *(unsigned short*)(B_ + OFF_QT + (8 * tg + j) * RS + k * 2) = (unsigned short)(pk2(qt, qt) & 0xffffu); *(unsigned short*)(B_ + OFF_KD + (8 * tg + j) * RS + k * 2) = (unsigned short)(pk2(kd, kd) & 0xffffu); } \
        v4u kw; kw.x = pk2(ke[0], ke[1]); kw.y = pk2(ke[2], ke[3]); kw.z = pk2(ke[4], ke[5]); kw.w = pk2(ke[6], ke[7]); *(v4u*)(B_ + OFF_KET + k * 64 + tg * 16) = kw; \
        v4u vw; vw.x = rv[s_][0] | (rv[s_][1] << 16); vw.y = rv[s_][2] | (rv[s_][3] << 16); vw.z = rv[s_][4] | (rv[s_][5] << 16); vw.w = rv[s_][6] | (rv[s_][7] << 16); \
        *(v4u*)(B_ + OFF_VT + k * 64 + tg * 16) = vw; \
        if (tg == 0) *(float*)(B_ + OFF_D + k * 4) = Pend; } while (0)
    f32x4 S[8];
#pragma unroll
    for (int i = 0; i < 8; ++i) S[i] = (f32x4){0.f, 0.f, 0.f, 0.f};
    const f32x4 z4 = (f32x4){0.f, 0.f, 0.f, 0.f};
    HG_LOAD(0, 0); HG_PREP(0, lds); HG_LOAD(1, 1);
    __syncthreads();
    const bool prep_first = (w < 4);
    for (int i2_ = 0; i2_ < NS; i2_ += 2) {
#pragma unroll
      for (int s = 0; s < 2; ++s) {
        const int i = i2_ + s;
        char* cur = lds + s * BUF; char* nxt = lds + (s ^ 1) * BUF;
        if (prep_first) { if (i + 1 < NS) { HG_PREP(s ^ 1, nxt); if (i + 2 < NS) HG_LOAD(s, i + 2); } }
        f32x4 st00 = z4, st01 = z4, st11 = z4;
        { bf16x8 kd0[4], qt0[4], qt1[4], kd1[4];
#pragma unroll
          for (int ks = 0; ks < 4; ++ks) { kd0[ks] = *(const bf16x8*)(cur + OFF_KD + c * RS + ks * 64 + g * 16); qt0[ks] = *(const bf16x8*)(cur + OFF_QT + c * RS + ks * 64 + g * 16); }
#pragma unroll
          for (int ks = 0; ks < 4; ++ks) st00 = __builtin_amdgcn_mfma_f32_16x16x32_bf16(kd0[ks], qt0[ks], st00, 0, 0, 0);
#pragma unroll
          for (int ks = 0; ks < 4; ++ks) qt1[ks] = *(const bf16x8*)(cur + OFF_QT + (16 + c) * RS + ks * 64 + g * 16);
#pragma unroll
          for (int ks = 0; ks < 4; ++ks) st01 = __builtin_amdgcn_mfma_f32_16x16x32_bf16(kd0[ks], qt1[ks], st01, 0, 0, 0);
#pragma unroll
          for (int ks = 0; ks < 4; ++ks) kd1[ks] = *(const bf16x8*)(cur + OFF_KD + (16 + c) * RS + ks * 64 + g * 16);
#pragma unroll
          for (int ks = 0; ks < 4; ++ks) st11 = __builtin_amdgcn_mfma_f32_16x16x32_bf16(kd1[ks], qt1[ks], st11, 0, 0, 0); }
#pragma unroll
        for (int r = 0; r < 4; ++r) if (4 * g + r > c) { st00[r] = 0.f; st11[r] = 0.f; }
        v2u pw; pw.x = pk2(st00[0], st00[1]); pw.y = pk2(st00[2], st00[3]); const bf16x4 pt00 = __builtin_bit_cast(bf16x4, pw);
        pw.x = pk2(st01[0], st01[1]); pw.y = pk2(st01[2], st01[3]); const bf16x4 pt01 = __builtin_bit_cast(bf16x4, pw);
        pw.x = pk2(st11[0], st11[1]); pw.y = pk2(st11[2], st11[3]); const bf16x4 pt11 = __builtin_bit_cast(bf16x4, pw);
        const bf16x4 vt0 = *(const bf16x4*)(cur + OFF_VT + (16 * w + c) * 64 + g * 8);
        const bf16x4 vt1 = *(const bf16x4*)(cur + OFF_VT + (16 * w + c) * 64 + 32 + g * 8);
        f32x4 o0 = __builtin_amdgcn_mfma_f32_16x16x16bf16_1k(pt00, vt0, z4, 0, 0, 0);
        f32x4 o1 = __builtin_amdgcn_mfma_f32_16x16x16bf16_1k(pt01, vt0, z4, 0, 0, 0);
        o1 = __builtin_amdgcn_mfma_f32_16x16x16bf16_1k(pt11, vt1, o1, 0, 0, 0);
#pragma unroll
        for (int kt = 0; kt < 8; ++kt) { const bf16x4 a0 = *(const bf16x4*)(cur + OFF_QT + c * RS + kt * 32 + g * 8); const bf16x4 a1 = *(const bf16x4*)(cur + OFF_QT + (16 + c) * RS + kt * 32 + g * 8);
            v2u sw; sw.x = pk2(S[kt][0], S[kt][1]); sw.y = pk2(S[kt][2], S[kt][3]); const bf16x4 sb = __builtin_bit_cast(bf16x4, sw);
            o0 = __builtin_amdgcn_mfma_f32_16x16x16bf16_1k(a0, sb, o0, 0, 0, 0); o1 = __builtin_amdgcn_mfma_f32_16x16x16bf16_1k(a1, sb, o1, 0, 0, 0); }
        { bf16* o_ = op + HG_RB(i);
#pragma unroll
          for (int r = 0; r < 4; ++r) { const unsigned w0 = pk2(o0[r], o0[r]), w1 = pk2(o1[r], o1[r]); o_[ooff[r]] = (unsigned short)(w0 & 0xffffu); o_[ooff[4 + r]] = (unsigned short)(w1 & 0xffffu); } }
        { const bf16x8 vb = *(const bf16x8*)(cur + OFF_VT + (16 * w + c) * 64 + g * 16);
#pragma unroll
          for (int kt = 0; kt < 8; ++kt) { const f32x4 d4 = *(const f32x4*)(cur + OFF_D + (16 * kt + 4 * g) * 4); const bf16x8 af = *(const bf16x8*)(cur + OFF_KET + (16 * kt + c) * 64 + g * 16);
              S[kt] = __builtin_amdgcn_mfma_f32_16x16x32_bf16(af, vb, S[kt] * d4, 0, 0, 0); } }
        if (!prep_first) { if (i + 1 < NS) { HG_PREP(s ^ 1, nxt); if (i + 2 < NS) HG_LOAD(s, i + 2); } }
        __syncthreads();
      }
    }
#undef HG_RB
#undef HG_LOAD
#undef HG_PREP
}
__device__ __forceinline__ void combine_rows(const Args& a, int layer, int gw, int NGW, int lane) {
    const bf16* QKV = (const bf16*)(a.ws + WS_QKV); bf16* MIX = (bf16*)(a.ws + WS_BUFA);
    const float* gn = a.in[12] + layer * 128 + (lane & 15) * 8; float gw8[8];
#pragma unroll
    for (int e = 0; e < 8; ++e) gw8[e] = gn[e];
    constexpr int CG = 4;
    const int rpw = ((MTOK + NGW - 1) / NGW + 7) & ~7; const int mbeg = gw * rpw, mend = (mbeg + rpw < MTOK) ? mbeg + rpw : MTOK;
    for (int m0 = mbeg; m0 < mend; m0 += CG) {
        v4u f[CG], b[CG], gg[CG]; int mq[CG];
#pragma unroll
        for (int q = 0; q < CG; ++q) { const int m = (m0 + q < mend) ? m0 + q : m0; mq[q] = m; const bf16* rowp = QKV + (size_t)m * INC + lane * 8;
            f[q] = *(const v4u*)(rowp + C_UF); b[q] = *(const v4u*)(rowp + C_UB); gg[q] = *(const v4u*)(rowp + C_G); }
        float o[CG][8], ss[CG];
#pragma unroll
        for (int q = 0; q < CG; ++q) { ss[q] = 0.f;
#pragma unroll
            for (int e = 0; e < 4; ++e) { o[q][2 * e] = bflo(f[q][e]) + bflo(b[q][e]); o[q][2 * e + 1] = bfhi(f[q][e]) + bfhi(b[q][e]); ss[q] += o[q][2 * e] * o[q][2 * e] + o[q][2 * e + 1] * o[q][2 * e + 1]; } }
#pragma unroll
        for (int st = 1; st < 16; st <<= 1) {
#pragma unroll
            for (int q = 0; q < CG; ++q) ss[q] += __shfl_xor(ss[q], st); }
#pragma unroll
        for (int q = 0; q < CG; ++q) { const float rs = __builtin_amdgcn_rsqf(ss[q] * (1.0f / 128.0f) + 1e-6f); v4u w;
#pragma unroll
            for (int e = 0; e < 4; ++e) w[e] = pk2(o[q][2 * e] * rs * gw8[2 * e] * pg8::silu_f(bflo(gg[q][e])), o[q][2 * e + 1] * rs * gw8[2 * e + 1] * pg8::silu_f(bfhi(gg[q][e])));
            *(v4u*)(MIX + (size_t)mq[q] * DM + lane * 8) = w; }
    }
}
}

__device__ __forceinline__ void rowpass(const Args& a, int layer, int which, int gw, int NGW, int lane) {
    float* xo = a.out; bf16* H = (bf16*)(a.ws + WS_BUFA); const bf16* Y = (const bf16*)(a.ws + WS_Y); const float* MOD = (const float*)(a.ws + WS_MOD);
    const int c0 = 4 * lane;
    f32x4 wpost[4], wpre[4];
    const float* wpostp = (which == 1) ? a.in[7] + layer * DM : a.in[9] + layer * DM;
    const int hl = (which == 2) ? layer + 1 : layer;
    const float* wprep = (which == 1) ? a.in[8] + layer * DM : a.in[6] + (hl < 2 ? hl : 0) * DM;
    const bool do_h = !(which == 2 && layer == 1);
#pragma unroll
    for (int j = 0; j < 4; ++j) { wpost[j] = *(const f32x4*)(wpostp + c0 + 256 * j); wpre[j] = *(const f32x4*)(wprep + c0 + 256 * j); }
    const int rpw = ((MTOK + NGW - 1) / NGW + 7) & ~7; const int mbeg = gw * rpw, mend = (mbeg + rpw < MTOK) ? mbeg + rpw : MTOK;
    f32x4 gt[4], sh[4], scl[4]; int cbl = -1;
    constexpr int RG = 4;
    for (int m0 = mbeg; m0 < mend; m0 += RG) {
        const int cb = m0 < NPROMPT ? (m0 >> 12) : 4 + ((m0 - NPROMPT) >> 11);
        if (cb != cbl) { cbl = cb;
            const float* modp = MOD + (size_t)(layer * NCB + cb) * 6144 + (which == 1 ? 2048 : 5120);
            const float* modh = MOD + (size_t)((hl < 2 ? hl : 0) * NCB + cb) * 6144 + (which == 1 ? 3072 : 0);
#pragma unroll
            for (int j = 0; j < 4; ++j) { gt[j] = *(const f32x4*)(modp + c0 + 256 * j); sh[j] = *(const f32x4*)(modh + c0 + 256 * j); scl[j] = *(const f32x4*)(modh + 1024 + c0 + 256 * j) + 1.0f; } }
        f32x4 x[RG][4]; v2u yr[RG][4]; int mq[RG];
#pragma unroll
        for (int q = 0; q < RG; ++q) { const int m = (m0 + q < mend) ? m0 + q : m0; mq[q] = m;
            const float* xin = (which == 0 || (which == 1 && layer == 0)) ? (m < NPROMPT ? a.in[0] + (size_t)m * DM : a.in[1] + (size_t)(m - NPROMPT) * DM) : xo + (size_t)m * DM;
#pragma unroll
            for (int j = 0; j < 4; ++j) { x[q][j] = *(const f32x4*)(xin + c0 + 256 * j); if (which != 0) yr[q][j] = *(const v2u*)(Y + (size_t)m * DM + c0 + 256 * j); } }
        if (which != 0) {
            float ss[RG]; f32x4 y[RG][4];
#pragma unroll
            for (int q = 0; q < RG; ++q) { ss[q] = 0.f;
#pragma unroll
                for (int j = 0; j < 4; ++j) { const v2u yw = yr[q][j]; y[q][j] = (f32x4){bflo(yw.x), bfhi(yw.x), bflo(yw.y), bfhi(yw.y)};
                    ss[q] += (y[q][j].x * y[q][j].x + y[q][j].y * y[q][j].y) + (y[q][j].z * y[q][j].z + y[q][j].w * y[q][j].w); } }
#pragma unroll
            for (int o = 1; o < 64; o <<= 1) {
#pragma unroll
                for (int q = 0; q < RG; ++q) ss[q] += __shfl_xor(ss[q], o); }
#pragma unroll
            for (int q = 0; q < RG; ++q) { const float r = __builtin_amdgcn_rsqf(ss[q] * (1.0f / DM) + 1e-6f);
#pragma unroll
                for (int j = 0; j < 4; ++j) { x[q][j] = x[q][j] + gt[j] * (y[q][j] * r * wpost[j]); *(f32x4*)(xo + (size_t)mq[q] * DM + c0 + 256 * j) = x[q][j]; } }
        }
        if (do_h) {
            float ss[RG];
#pragma unroll
            for (int q = 0; q < RG; ++q) { ss[q] = 0.f;
#pragma unroll
                for (int j = 0; j < 4; ++j) ss[q] += (x[q][j].x * x[q][j].x + x[q][j].y * x[q][j].y) + (x[q][j].z * x[q][j].z + x[q][j].w * x[q][j].w); }
#pragma unroll
            for (int o = 1; o < 64; o <<= 1) {
#pragma unroll
                for (int q = 0; q < RG; ++q) ss[q] += __shfl_xor(ss[q], o); }
#pragma unroll
            for (int q = 0; q < RG; ++q) { const float r = __builtin_amdgcn_rsqf(ss[q] * (1.0f / DM) + 1e-6f);
#pragma unroll
                for (int j = 0; j < 4; ++j) { const f32x4 h = x[q][j] * r * wpre[j] * scl[j] + sh[j]; v2u w; w.x = pk2(h.x, h.y); w.y = pk2(h.z, h.w); *(v2u*)(H + (size_t)mq[q] * DM + c0 + 256 * j) = w; } }
        }
    }
}

__device__ __forceinline__ void transpose_item(const float* W, int K, int N, bf16* WT, int dn0, int sn0, int k0, LAS float* scr, int lane) {
#pragma unroll 8
    for (int i = 0; i < 32; ++i) { const int kk = 2 * i + (lane >> 5); scr[kk * 33 + (lane & 31)] = W[(size_t)(k0 + kk) * N + sn0 + (lane & 31)]; }
    asm volatile("s_waitcnt lgkmcnt(0)" ::: "memory");
    const int c = lane & 7;
#pragma unroll
    for (int j = 0; j < 4; ++j) { const int n = (lane >> 3) + 8 * j; const LAS float* s = scr + (8 * c) * 33 + n;
        v4u o; o.x = pk2(s[0 * 33], s[1 * 33]); o.y = pk2(s[2 * 33], s[3 * 33]); o.z = pk2(s[4 * 33], s[5 * 33]); o.w = pk2(s[6 * 33], s[7 * 33]);
        *(v4u*)(WT + (size_t)(dn0 + n) * K + k0 + 8 * c) = o; }
    asm volatile("s_waitcnt lgkmcnt(0)" ::: "memory");
}
__device__ __forceinline__ void convert_weights(const Args& a, int layer, LAS unsigned char* lds, int gw, int NGW, int wave, int lane) {
    LAS float* scr = (LAS float*)(lds + wave * 16384);
    constexpr int I_IN = 16 * 128, I_OUT = 16 * 32, I_1 = 16 * 176, I_2 = 44 * 32, NITEMS = I_IN + I_OUT + I_1 + I_2;
    bf16* WinT = (bf16*)(a.ws + WS_WIN); bf16* WoutT = (bf16*)(a.ws + WS_WOUT); bf16* W1T = (bf16*)(a.ws + WS_W1); bf16* W2T = (bf16*)(a.ws + WS_W2);
    for (int it = gw; it < NITEMS; it += NGW) {
        int r = it;
        if (r < I_IN) { const int kb = r / 128, nb = r % 128, dn0 = nb * 32; int sn0 = dn0; const int blk = dn0 / 512;
            if (blk == 5 || blk == 6) { const int tile = dn0 / 256, g = dn0 % 256, half = g / 128, head = (g % 128) / 32; sn0 = tile * 256 + head * 64 + half * 32; }
            transpose_item(a.in[10] + (size_t)layer * DM * INC, DM, INC, WinT, dn0, sn0, kb * 64, scr, lane); continue; } r -= I_IN;
        if (r < I_OUT) { const int kb = r / 32, nb = r % 32; transpose_item(a.in[18] + (size_t)layer * DM * DM, DM, DM, WoutT, nb * 32, nb * 32, kb * 64, scr, lane); continue; } r -= I_OUT;
        if (r < I_1) { const int kb = r / 176, nb = r % 176, dn0 = nb * 32; const int pn = dn0 / 256, bj = (dn0 % 256) / 128, x = dn0 % 128;
            transpose_item((bj ? a.in[20] : a.in[19]) + (size_t)layer * DM * FFH, DM, FFH, W1T, dn0, 128 * pn + x, kb * 64, scr, lane); continue; } r -= I_1;
        { const int kb = r / 32, nb = r % 32; transpose_item(a.in[21] + (size_t)layer * FFH * DM, FFH, DM, W2T, nb * 32, nb * 32, kb * 64, scr, lane); }
    }
}
__device__ __forceinline__ void mod_item(const Args& a, int item, LAS unsigned char* lds, int tid, int wave, int lane) {
    LAS float* sc = (LAS float*)lds; LAS float* red = (LAS float*)(lds + 81920);
    const int l = item / 96, n0 = (item % 96) * 64;
    for (int i = tid; i < NCB * DM; i += 512) { const int cb = i >> 10, k = i & 1023; const float v = cb < 4 ? a.in[2][cb * DM + k] : a.in[3][(cb - 4) * DM + k];
        sc[i] = v / (1.0f + __expf(-v)); }
    __syncthreads();
    float acc[NCB];
#pragma unroll
    for (int cb = 0; cb < NCB; ++cb) acc[cb] = 0.f;
    const float* wp = a.in[4] + (size_t)l * DM * 6144 + n0 + lane;
    for (int k = wave * 128; k < wave * 128 + 128; ++k) { const float wv = wp[(size_t)k * 6144];
#pragma unroll
        for (int cb = 0; cb < NCB; ++cb) acc[cb] += sc[cb * DM + k] * wv; }
#pragma unroll
    for (int cb = 0; cb < NCB; ++cb) red[(wave * NCB + cb) * 64 + lane] = acc[cb];
    __syncthreads();
    float* MOD = (float*)(a.ws + WS_MOD);
    for (int i = tid; i < NCB * 64; i += 512) { const int cb = i >> 6, ln = i & 63; float s = a.in[5][l * 6144 + n0 + ln];
#pragma unroll
        for (int w = 0; w < 8; ++w) s += red[(w * NCB + cb) * 64 + ln];
        MOD[(size_t)(l * NCB + cb) * 6144 + n0 + ln] = s; }
    __syncthreads();
}

#define XB_TMO      128
#define XB_XCNT(j)  (256  + 64 * (j))
#define XB_XSUB(j)  (1280 + 64 * (j))
#define XB_XGEN(j)  (2304 + 64 * (j))
#define XB_TOP      3328
#define XB_TOPGEN   3392
#define XCD_BAR_WORDS 3456
#define XB_SPIN_CAP (1u << 18)

__device__ __forceinline__ unsigned xb_ld(unsigned* p)              { return __hip_atomic_load(p, __ATOMIC_RELAXED, __HIP_MEMORY_SCOPE_AGENT); }
__device__ __forceinline__ unsigned xb_add(unsigned* p, unsigned v) { return __hip_atomic_fetch_add(p, v, __ATOMIC_RELAXED, __HIP_MEMORY_SCOPE_AGENT); }
__device__ __forceinline__ unsigned xb_xcc_id() { return (unsigned)__builtin_amdgcn_s_getreg((3 << 11) | 20) & 0xFu; }
#define XB_SPIN(cond, bar) do { unsigned _sp = 0; while (cond) { __builtin_amdgcn_s_sleep(1); \
    if ((++_sp & 255u) == 0u) { if (xb_ld(&(bar)[XB_TMO])) break; if (_sp > XB_SPIN_CAP) { atomicAdd(&(bar)[XB_TMO], 1u); break; } } } } while (0)

struct XcdBarrier {
    unsigned* bar; unsigned x;
    volatile LAS unsigned* st;
};

__device__ __forceinline__ XcdBarrier xcd_barrier_post(unsigned* bar, volatile LAS unsigned* st) {
    XcdBarrier b; b.bar = bar; b.x = xb_xcc_id(); b.st = st;
    if (threadIdx.x == 0) (void)xb_add(&bar[XB_XCNT(b.x)], 1u);
    return b;
}
__device__ __forceinline__ void xcd_barrier_complete(unsigned* bar, unsigned x, unsigned& nloc, unsigned& nx) {
    const unsigned G = gridDim.x * gridDim.y * gridDim.z;
    unsigned sum, cnt, mine, sp = 0u;
    for (;;) {
        sum = 0u; cnt = 0u; mine = 0u;
#pragma unroll
        for (unsigned j = 0; j < 16; ++j) { const unsigned c = xb_ld(&bar[XB_XCNT(j)]); sum += c; cnt += (c > 0u) ? 1u : 0u; mine = (j == x) ? c : mine; }
        if (sum == G) break;
        __builtin_amdgcn_s_sleep(1);
        if ((++sp & 255u) == 0u) { if (xb_ld(&bar[XB_TMO])) break; if (sp > XB_SPIN_CAP) { atomicAdd(&bar[XB_TMO], 1u); break; } }
    }
    nloc = mine > 0u ? mine : 1u; nx = cnt > 0u ? cnt : 1u;
}

__device__ __forceinline__ void xcd_barrier(const XcdBarrier& b) {
    asm volatile("s_waitcnt vmcnt(0)" ::: "memory");
    __syncthreads();
    if (threadIdx.x == 0) {
        unsigned* bar = b.bar;
        __builtin_amdgcn_s_waitcnt(0);
        unsigned nloc = b.st[0], nx = b.st[1];
        if (nloc == 0u) { xcd_barrier_complete(bar, b.x, nloc, nx); b.st[0] = nloc; b.st[1] = nx; }
        const unsigned old = xb_add(&bar[XB_XSUB(b.x)], 1u);
        const unsigned gen = old / nloc;
        if (old + 1u == (gen + 1u) * nloc) {
            __builtin_amdgcn_fence(__ATOMIC_RELEASE, "agent");
            asm volatile("s_waitcnt vmcnt(0)" ::: "memory");
            const unsigned og = xb_add(&bar[XB_TOP], 1u);
            const unsigned tg = og / nx;
            if (og + 1u == (tg + 1u) * nx) xb_add(&bar[XB_TOPGEN], 1u);
            else XB_SPIN(xb_ld(&bar[XB_TOPGEN]) == tg, bar);
            __builtin_amdgcn_fence(__ATOMIC_ACQUIRE, "agent");
            xb_add(&bar[XB_XGEN(b.x)], 1u);
            asm volatile("s_waitcnt vmcnt(0)" ::: "memory");
        } else {
            XB_SPIN(xb_ld(&bar[XB_XGEN(b.x)]) == gen, bar);
            __builtin_amdgcn_fence(__ATOMIC_ACQUIRE, "agent");
            asm volatile("s_waitcnt vmcnt(0)" ::: "memory");
        }
    }
    __syncthreads();
}

constexpr int LDS_BYTES = 147456;
constexpr int NPH = 18;
#ifndef REP_ATT
#define REP_ATT 1
#endif
#ifndef REP_GEMM
#define REP_GEMM 1
#endif
#ifndef REP_PRO
#define REP_PRO 1
#endif
#ifndef REP_ROW0
#define REP_ROW0 1
#endif
#ifndef EXTRA_SYNC
#define EXTRA_SYNC 0
#endif
#ifndef REP_HGC
#define REP_HGC 1
#endif
__global__ void __launch_bounds__(512, 2) mega_fwd(Args a) {
    extern __shared__ __attribute__((aligned(16))) unsigned char lds[];
    cg::grid_group grid = cg::this_grid();
    const int tid = threadIdx.x, lane = tid & 63, wave = __builtin_amdgcn_readfirstlane(tid >> 6);
    const int G = gridDim.x, bx = blockIdx.x;
    const int vcu = (G % 8 == 0) ? (bx % 8) * (G / 8) + bx / 8 : bx;
    const int gw = vcu * 8 + wave, NGW = G * 8;
    LAS unsigned char* lds3 = (LAS unsigned char*)lds;
    const int lo = a.ph_lo, hi = a.ph_hi;
    if (tid < 8) ((LAS unsigned*)(lds3 + LDS_BYTES - 32))[tid] = 0u;
    __syncthreads();
    XcdBarrier bar; bar.bar = (unsigned*)(a.ws + WS_BAR); bar.x = 0; bar.st = (volatile LAS unsigned*)(lds3 + LDS_BYTES - 32);
#define IN(k) (lo <= (k) && (k) < hi)
#define SEAM(k) do { if ((k) + 1 < hi) { if ((k) == 0) { grid.sync(); bar = xcd_barrier_post((unsigned*)(a.ws + WS_BAR), (volatile LAS unsigned*)(lds3 + LDS_BYTES - 32)); } else xcd_barrier(bar); } } while (0)
    bf16* BUFA = (bf16*)(a.ws + WS_BUFA); bf16* QKV = (bf16*)(a.ws + WS_QKV); bf16* YB = (bf16*)(a.ws + WS_Y);
    const float* cosT = (const float*)(a.ws + WS_COS); const float* sinT = (const float*)(a.ws + WS_SIN);

    if (IN(0)) {
      for (int rep = 0; rep < REP_PRO; ++rep) {
        int ln = lane, td = tid; asm volatile("" : "+v"(ln), "+v"(td));

#ifndef NO_MOD
        for (int item = bx; item < 192; item += G) mod_item(a, item, lds3, td, wave, ln);
#endif

        for (int gt = bx * 512 + td; gt < 4096 * 32; gt += G * 512) { { const int t = gt >> 5, i = gt & 31;
            const float inv = __builtin_amdgcn_exp2f(-(float)i * (13.287712379549449f / 32.0f));
            float rev = (float)t * inv * 0.15915494309189535f; rev = rev - floorf(rev);
            ((float*)(a.ws + WS_COS))[gt] = __builtin_amdgcn_cosf(rev); ((float*)(a.ws + WS_SIN))[gt] = __builtin_amdgcn_sinf(rev); } }
        if (bx == 0 && td < 16) ((unsigned*)(a.ws + WS_CTR))[64 * td] = 0u;
        if (bx == 0) for (int i = td; i < XCD_BAR_WORDS; i += 512) ((unsigned*)(a.ws + WS_BAR))[i] = 0u;
        convert_weights(a, 0, lds3, gw, NGW, wave, ln);
        __syncthreads();
      }
        for (int e = 0; e < EXTRA_SYNC; ++e) grid.sync();
        SEAM(0);
    }
    if (IN(1)) { for (int rep = 0; rep < REP_ROW0; ++rep) { int ln = lane; asm volatile("" : "+v"(ln)); rowpass(a, 0, 0, gw, NGW, ln); } SEAM(1); }
#pragma unroll 1
    for (int layer = 0; layer < 2; ++layer) {
        const int pb = 2 + 8 * layer;
        if (IN(pb + 0)) {
            pg8::Gemm g{BUFA, (const bf16*)(a.ws + WS_WIN), MTOK, INC, DM}; pg8::StaticOrder S; S.init(MTOK, INC, G, bx);
            pg8::EpiIn E{QKV, INC, cosT, sinT, 0.125f * 1.4426950408889634f};

#ifndef NO_GIN
            for (int rep = 0; rep < REP_GEMM; ++rep) pg8::gemm_phase<pg8::EpiIn, pg8::StaticOrder, true, true>(lds3, g, S, E);
#endif

            SEAM(pb + 0);
        }
        if (IN(pb + 1)) {
            int ln = lane; asm volatile("" : "+v"(ln));
            float s1 = a.in[13][layer * 64 + ln] * a.in[14][layer * 64 + ln], s2 = a.in[15][layer * 64 + ln] * a.in[16][layer * 64 + ln];
            s1 = wave_sum(s1); s2 = wave_sum(s2);
            const float linit = 0.8f - 0.6f * __expf(-0.3f * (float)layer);
            const float lam = __expf(s1) - __expf(s2) + linit, post = 1.0f - linit;
            const float* subln = a.in[17] + layer * 128;
            unsigned* ctr = (unsigned*)(a.ws + WS_CTR) + 64 * 8 * layer;
            volatile LAS unsigned* qslot = (volatile LAS unsigned*)(lds3 + LDS_BYTES - 64);
            int myq = (int)(xb_xcc_id() & 7u), adv = 0;
            constexpr int QLEN = 20 + 64 + 128;
            for (;;) {
                __syncthreads();
                if (tid == 0) { unsigned v = 0xffffffffu;
                    while (adv < 8) { v = __hip_atomic_fetch_add(ctr + 64 * myq, 1u, __ATOMIC_RELAXED, __HIP_MEMORY_SCOPE_AGENT); if (v < (unsigned)QLEN) break; v = 0xffffffffu; myq = (myq + 1) & 7; ++adv; }
                    *qslot = (v == 0xffffffffu) ? v : (((unsigned)myq << 16) | v); }
                __syncthreads();
                const unsigned qw = *qslot;
                if (qw == 0xffffffffu) break;
                const int qx = (int)(qw >> 16), li = (int)(qw & 0xffffu);
                int idx;
                if (li < 4) idx = qx * 4 + li;
                else if (li < 20) idx = 32 + qx * 16 + (li - 4);
                else if (li < 84) { const int j = li - 20; idx = 160 + (qx + 8 * (j >> 5)) * 32 + (j & 31); }
                else { const int j = li - 84; idx = 160 + 512 + (qx + 8 * (j >> 4)) * 16 + (j & 15); }
                if (idx < 160) {
#ifndef NO_HG
                    hg::chain(a, layer, idx, (char*)lds);
#endif
                } else {
                    const int u = idx - 160; int cb, hd, qb, T, row0;
                    if (u < 512) { cb = u >> 7; hd = (u >> 5) & 3; qb = u & 31; T = TP; row0 = cb * TP; }
                    else { const int u2 = u - 512; cb = 4 + (u2 >> 6); hd = (u2 >> 4) & 3; qb = u2 & 15; T = TS; row0 = NPROMPT + (cb - 4) * TS; }
                    const bf16* Qb = QKV + (size_t)(row0 + qb * 128) * INC + C_DQ + 128 * hd;
                    const bf16* Kh = QKV + (size_t)row0 * INC + C_DK + 128 * hd; const bf16* Vh = QKV + (size_t)row0 * INC + C_DV + 128 * hd;
                    bf16* Ob = BUFA + (size_t)(row0 + qb * 128) * DM + 512 + 128 * hd;
#ifndef NO_ATT
                    for (int rep = 0; rep < REP_ATT; ++rep) att::attn_unit(Qb, Kh, Vh, Ob, T, (char*)lds, lam, post, subln);
#endif
                }
            }
            SEAM(pb + 1);
        }
        if (IN(pb + 2)) { int ln = lane; asm volatile("" : "+v"(ln)); hg::combine_rows(a, layer, gw, NGW, ln); SEAM(pb + 2); }
        if (IN(pb + 3)) {
            pg8::Gemm g{BUFA, (const bf16*)(a.ws + WS_WOUT), MTOK, DM, DM}; pg8::StaticOrder S; S.init(MTOK, DM, G, bx);
            pg8::EpiPlain E{YB, DM};

#ifndef NO_GPL
            for (int rep = 0; rep < REP_GEMM; ++rep) pg8::gemm_phase<pg8::EpiPlain, pg8::StaticOrder, true, true>(lds3, g, S, E);
#endif

            SEAM(pb + 3);
        }
        if (IN(pb + 4)) { int ln = lane; asm volatile("" : "+v"(ln)); rowpass(a, layer, 1, gw, NGW, ln); SEAM(pb + 4); }
        if (IN(pb + 5)) {
            pg8::Gemm g{BUFA, (const bf16*)(a.ws + WS_W1), MTOK, 2 * FFH, DM}; pg8::StaticOrder S; S.init(MTOK, 2 * FFH, G, bx);
            pg8::EpiSwiGLU E{QKV, FFH};

#ifndef NO_GSW
            for (int rep = 0; rep < REP_GEMM; ++rep) pg8::gemm_phase<pg8::EpiSwiGLU, pg8::StaticOrder, true, true>(lds3, g, S, E);
#endif

            SEAM(pb + 5);
        }
        if (IN(pb + 6)) {
            pg8::Gemm g{QKV, (const bf16*)(a.ws + WS_W2), MTOK, DM, FFH}; pg8::StaticOrder S; S.init(MTOK, DM, G, bx, 1);
            pg8::EpiPlain E{YB, DM};

#ifndef NO_GPL
            for (int rep = 0; rep < REP_GEMM; ++rep) pg8::gemm_phase<pg8::EpiPlain, pg8::StaticOrder, true, true>(lds3, g, S, E);
#endif

            SEAM(pb + 6);
        }
        if (IN(pb + 7)) {
            int ln = lane; asm volatile("" : "+v"(ln));
            rowpass(a, layer, 2, gw, NGW, ln);
            if (layer == 0) convert_weights(a, 1, lds3, gw, NGW, wave, ln);
            SEAM(pb + 7);
        }
    }
#undef IN
#undef SEAM
}


#ifndef DBG_STOP
#define DBG_STOP 0
#endif
#ifndef DBG_DUMP
#define DBG_DUMP 0
#endif
__global__ void dbg_dump(Args a, int which) {
    const size_t n = (size_t)MTOK * DM;
    for (size_t i = (size_t)blockIdx.x * blockDim.x + threadIdx.x; i < n; i += (size_t)gridDim.x * blockDim.x) {
        const size_t m = i >> 10, c = i & 1023; float v = 0.f;
        if (which == 1) { const bf16* q = (const bf16*)(a.ws + WS_QKV) + m * INC + c; v = bf2f(q[0]) + bf2f(q[1024]) + bf2f(q[2048]) + bf2f(q[3072]); }
        else if (which == 2) v = bf2f(((const bf16*)(a.ws + WS_BUFA))[i]);
        else if (which == 3) v = bf2f(((const bf16*)(a.ws + WS_Y))[i]);
        a.out[i] = v;
    }
}
#ifndef MK_MULTI
#define MK_MULTI 0
#endif
extern "C" void kernel_launch(void* const* d_in, const int* in_sizes, int n_in, void* d_out, int out_size, void* d_ws, size_t ws_size, hipStream_t stream) {
    static int grid = 0;
    if (grid == 0) {
        if (n_in != 22 || out_size != MTOK * DM || ws_size < WS_END) { fprintf(stderr, "kernel_launch: unexpected shapes: n_in %d out %d ws %zu (need %zu)\n", n_in, out_size, ws_size, (size_t)WS_END); grid = -1; return; }
        int dev = 0, cus = 0, per_cu = 0;
        if (hipGetDevice(&dev) != hipSuccess || hipDeviceGetAttribute(&cus, hipDeviceAttributeMultiprocessorCount, dev) != hipSuccess) { grid = -1; return; }
        if (hipFuncSetAttribute((const void*)mega_fwd, hipFuncAttributeMaxDynamicSharedMemorySize, LDS_BYTES) != hipSuccess) { fprintf(stderr, "kernel_launch: hipFuncSetAttribute failed\n"); grid = -1; return; }
        if (hipOccupancyMaxActiveBlocksPerMultiprocessor(&per_cu, (const void*)mega_fwd, 512, LDS_BYTES) != hipSuccess || per_cu < 1) { fprintf(stderr, "kernel_launch: occupancy query says %d\n", per_cu); per_cu = 1; }
        (void)hipGetLastError();
        grid = cus;
    }
    if (grid < 0) return;
    Args a{};
    for (int i = 0; i < 22; ++i) a.in[i] = (const float*)d_in[i];
    a.out = (float*)d_out; a.ws = (unsigned char*)d_ws;
#if MK_MULTI
    for (int ph = 0; ph < (DBG_STOP ? DBG_STOP : NPH); ++ph) { a.ph_lo = ph; a.ph_hi = ph + 1; hipLaunchKernelGGL(mega_fwd, dim3(grid), dim3(512), LDS_BYTES, stream, a); }
    if (DBG_DUMP) hipLaunchKernelGGL(dbg_dump, dim3(2048), dim3(256), 0, stream, a, DBG_DUMP);
#else
    a.ph_lo = 0; a.ph_hi = NPH;
    void* args[] = {&a};
    hipError_t e = hipLaunchCooperativeKernel((const void*)mega_fwd, dim3(grid), dim3(512), args, LDS_BYTES, stream);
    if (e != hipSuccess) fprintf(stderr, "cooperative launch failed: %s (grid %d)\n", hipGetErrorString(e), grid);
#endif
}
```

```cpp
#include <hip/hip_runtime.h>
#include <hip/hip_bf16.h>
#include <hip/hip_cooperative_groups.h>
#include <cstdio>
#include <cstdint>
namespace cg = cooperative_groups;

namespace pg8 {
#define PG8_LAS __attribute__((address_space(3)))
typedef unsigned short bf16_t;
typedef short bf16x8 __attribute__((ext_vector_type(8)));
typedef float f32x4 __attribute__((ext_vector_type(4)));
typedef unsigned u32x4 __attribute__((ext_vector_type(4)));
constexpr int BM = 256, BK = 64, HALF = 128, HTB = HALF * BK * 2  , STAGE_BYTES = 8 * HTB, NXCD = 8, WGM = 8;

__host__ __device__ __forceinline__ int lds_byte(int r, int c) { const int st = (r >> 4) * 2 + (c >> 5), rr = r & 15, cc = c & 31, ob = rr * 64 + cc * 2; return st * 1024 + (ob ^ (((ob >> 9) & 1) << 5)); }
__host__ __device__ __forceinline__ void stage_rc(int b, int& R, int& C) { const int st = b / 1024, sb = b % 1024, swz = sb ^ (((sb >> 9) & 1) << 5); R = (st >> 1) * 16 + swz / 64; C = (st & 1) * 32 + (swz % 64) / 2; }
__host__ __device__ __forceinline__ int perm32(int rho) { const int n = rho >> 4, i = rho & 15; return 8 * (i >> 2) + 4 * n + (i & 3); }

struct Unit { int pm, pn; };
struct Gemm { const bf16_t* A; const bf16_t* Bt; int M, N, K; };

struct StaticOrder {
    int nM, nN, nwg, G, c, rev;
    __host__ __device__ void init(int M, int N, int G_, int c_, int rev_ = 0) { nM = M / BM; nN = N / BM; nwg = nM * nN; G = G_; c = c_; rev = rev_; }
    __host__ __device__ bool next(int i, Unit& u) const {
        const long L = (long)i * G + c; if (L >= nwg) return false;
        int wgid = (int)L; { const int q = nwg / NXCD, r = nwg % NXCD, xcd = wgid % NXCD, off = wgid / NXCD; wgid = (xcd < r ? xcd * (q + 1) : r * (q + 1) + (xcd - r) * q) + off; }
        const int nig = WGM * nN, gid = wgid / nig, fm = gid * WGM, gsz = (nM - fm) < WGM ? (nM - fm) : WGM;
        u.pm = fm + ((wgid % nig) % gsz); u.pn = (wgid % nig) / gsz; if (rev) u.pm = nM - 1 - u.pm; return true;
    }
    __device__ __forceinline__ void a_ready(const Unit&) const {}
    __device__ __forceinline__ void done(const Unit&) const {}
};

typedef float f32x2_t __attribute__((ext_vector_type(2))); typedef __bf16 bf16x2_t __attribute__((ext_vector_type(2)));
__device__ __forceinline__ unsigned cvt_pk_bf16(float lo, float hi) { f32x2_t v = {lo, hi}; bf16x2_t b = __builtin_convertvector(v, bf16x2_t); return __builtin_bit_cast(unsigned, b); }
__device__ __forceinline__ float fast_rcp(float x) { return __builtin_amdgcn_rcpf(x); }
__device__ __forceinline__ float silu_f(float x) { return x * fast_rcp(1.0f + __builtin_amdgcn_exp2f(-1.4426950408889634f * x)); }
__device__ __forceinline__ float signeg_f(float x) { return fast_rcp(1.0f + __builtin_amdgcn_exp2f(1.4426950408889634f * x)); }
__device__ __forceinline__ u32x4 pack8(const f32x4& a, const f32x4& b) { u32x4 w; w.x = cvt_pk_bf16(a[0], a[1]); w.y = cvt_pk_bf16(a[2], a[3]); w.z = cvt_pk_bf16(b[0], b[1]); w.w = cvt_pk_bf16(b[2], b[3]); return w; }

struct EpiPlain {
    static constexpr bool PERM = true, AFTER_DRAIN = false;
    bf16_t* O; int ldc;
    __device__ __forceinline__ void operator()(const f32x4 (&acc)[2][2][4][2], const Unit& u, int wr, int wc, int fr, int fq) const {
        const int row0 = u.pm * BM + wr * 64 + fr, col0 = u.pn * BM + wc * 32 + 8 * fq;
#pragma unroll
        for (int ai = 0; ai < 2; ++ai)
#pragma unroll
            for (int m = 0; m < 4; ++m) { bf16_t* rowp = O + (size_t)(row0 + ai * HALF + m * 16) * ldc + col0;
#pragma unroll
                for (int bj = 0; bj < 2; ++bj) *(u32x4*)(rowp + bj * HALF) = pack8(acc[ai][bj][m][0], acc[ai][bj][m][1]); }
    }
};
struct EpiSwiGLU {
    static constexpr bool PERM = true, AFTER_DRAIN = false;
    bf16_t* O; int ldc;
    __device__ __forceinline__ void operator()(const f32x4 (&acc)[2][2][4][2], const Unit& u, int wr, int wc, int fr, int fq) const {
        const int row0 = u.pm * BM + wr * 64 + fr, col0 = u.pn * HALF + wc * 32 + 8 * fq;
#pragma unroll
        for (int ai = 0; ai < 2; ++ai)
#pragma unroll
            for (int m = 0; m < 4; ++m) { bf16_t* rowp = O + (size_t)(row0 + ai * HALF + m * 16) * ldc + col0;
                f32x4 h0, h1;
#pragma unroll
                for (int e = 0; e < 4; ++e) { h0[e] = silu_f(acc[ai][0][m][0][e]) * acc[ai][1][m][0][e]; h1[e] = silu_f(acc[ai][0][m][1][e]) * acc[ai][1][m][1][e]; }
                *(u32x4*)rowp = pack8(h0, h1); }
    }
};
struct EpiIn {
    static constexpr bool PERM = true, AFTER_DRAIN = false;
    bf16_t* O; int ldc; const float* cosT; const float* sinT; float qscale;
    __device__ __forceinline__ void operator()(const f32x4 (&acc)[2][2][4][2], const Unit& u, int wr, int wc, int fr, int fq) const {
        const int row0 = u.pm * BM + wr * 64 + fr; const int blk = u.pn >> 1;
        if (blk == 5 || blk == 6) {
            const float sc = (blk == 5) ? qscale : 1.0f; const int colh = u.pn * BM + 64 * wc + 8 * fq;
#pragma unroll
            for (int ai = 0; ai < 2; ++ai)
#pragma unroll
                for (int m = 0; m < 4; ++m) { const int row = row0 + ai * HALF + m * 16; const int t = row < 16384 ? (row & 4095) : (row & 2047);
                    bf16_t* rowp = O + (size_t)row * ldc + colh; f32x4 o1[2], o2[2];
#pragma unroll
                    for (int n = 0; n < 2; ++n) { const f32x4 c4 = *(const f32x4*)(cosT + t * 32 + 8 * fq + 4 * n), s4 = *(const f32x4*)(sinT + t * 32 + 8 * fq + 4 * n);
                        const f32x4 x1 = acc[ai][0][m][n], x2 = acc[ai][1][m][n];
                        o1[n] = (x1 * c4 - x2 * s4) * sc; o2[n] = (x2 * c4 + x1 * s4) * sc; }
                    *(u32x4*)rowp = pack8(o1[0], o1[1]); *(u32x4*)(rowp + 32) = pack8(o2[0], o2[1]); }
        } else {
            const int act = (blk == 0) ? 1 : ((blk == 1 || blk == 2) ? 2 : 0);     const int col0 = u.pn * BM + wc * 32 + 8 * fq;
#pragma unroll
            for (int ai = 0; ai < 2; ++ai)
#pragma unroll
                for (int m = 0; m < 4; ++m) { bf16_t* rowp = O + (size_t)(row0 + ai * HALF + m * 16) * ldc + col0;
#pragma unroll
                    for (int bj = 0; bj < 2; ++bj) { f32x4 v0 = acc[ai][bj][m][0], v1 = acc[ai][bj][m][1];
                        if (act == 1) {
#pragma unroll
                            for (int e = 0; e < 4; ++e) { v0[e] = silu_f(v0[e]); v1[e] = silu_f(v1[e]); } }
                        else if (act == 2) {
#pragma unroll
                            for (int e = 0; e < 4; ++e) { v0[e] = signeg_f(v0[e]); v1[e] = signeg_f(v1[e]); } }
                        *(u32x4*)(rowp + bj * HALF) = pack8(v0, v1); } }
        }
    }
};

template <class Epi, class Sched, bool ALIGN_EPI = false, bool SP2 = false>
__device__ __forceinline__ void gemm_phase(PG8_LAS unsigned char* lds, const Gemm g, const Sched& S, const Epi& E) {
    int tid_l = threadIdx.x; asm volatile("" : "+v"(tid_l));
    const int tid = tid_l, wid = __builtin_amdgcn_readfirstlane(tid >> 6), lane = tid & 63, wr = wid >> 2, wc = wid & 3, fr = lane & 15, fq = lane >> 4;
    const int K = g.K, nt = K / BK;
    unsigned voffA[2], voffB[2];
#pragma unroll
    for (int i = 0; i < 2; ++i) { int R, C; stage_rc(tid * 16 + i * 8192, R, C); const int Rb = Epi::PERM ? ((R & ~31) + perm32(R & 31)) : R;
        voffA[i] = (unsigned)(R * K + C) * 2u; voffB[i] = (unsigned)(Rb * K + C) * 2u; }
    const size_t kstep = (size_t)(BK * 2);
    const size_t hstep = (size_t)HALF * K * 2;
    const size_t tstep = 2 * hstep;
    const unsigned ldsw = (unsigned)wid * 1024u;
    const int aoff = lds_byte(wr * 64 + fr, fq * 8), boff = lds_byte(wc * 32 + fr, fq * 8);
#define PG8_SA(b, h) (((b) * 2 + (h)) * HTB)
#define PG8_SB(b, h) ((4 + (b) * 2 + (h)) * HTB)
#define PG8_STAGE(bufoff, gbase, voff) do { _Pragma("unroll") for (int _i = 0; _i < 2; ++_i) \
        __builtin_amdgcn_global_load_lds((const unsigned*)((const char*)(gbase) + (voff)[_i]), (PG8_LAS unsigned*)(lds + (bufoff) + ldsw + _i * 8192), 16, 0, 0); } while (0)
#define PG8_LDA(dst, b, h) do { _Pragma("unroll") for (int m = 0; m < 4; ++m) _Pragma("unroll") for (int k = 0; k < 2; ++k) dst[m][k] = *(const PG8_LAS bf16x8*)(lds + PG8_SA(b, h) + aoff + m * 2048 + k * 1024); } while (0)
#define PG8_LDB(dst, b, h) do { _Pragma("unroll") for (int n = 0; n < 2; ++n) _Pragma("unroll") for (int k = 0; k < 2; ++k) dst[n][k] = *(const PG8_LAS bf16x8*)(lds + PG8_SB(b, h) + boff + n * 2048 + k * 1024); } while (0)
#define PG8_MMA(ai, bj, At, Bt) do { __builtin_amdgcn_s_setprio(1); _Pragma("unroll") for (int m = 0; m < 4; ++m) _Pragma("unroll") for (int n = 0; n < 2; ++n) _Pragma("unroll") for (int k = 0; k < 2; ++k) \
        acc[ai][bj][m][n] = __builtin_amdgcn_mfma_f32_16x16x32_bf16(Bt[n][k], At[m][k], acc[ai][bj][m][n], 0, 0, 0); __builtin_amdgcn_s_setprio(0); } while (0)
#define PG8_WAIT_V(n) asm volatile("s_waitcnt vmcnt(" #n ")" ::: "memory")
#define PG8_WAIT_L(n) asm volatile("s_waitcnt lgkmcnt(" #n ")" ::: "memory")
#define PG8_BAR __builtin_amdgcn_s_barrier()
#define PG8_SCHED __builtin_amdgcn_sched_barrier(0)
    Unit cur, nxt; int ui = 0;
    if (!S.next(0, cur)) return;
    f32x4 acc[2][2][4][2];
#pragma unroll
    for (int a = 0; a < 2; ++a)
#pragma unroll
        for (int b = 0; b < 2; ++b)
#pragma unroll
            for (int m = 0; m < 4; ++m)
#pragma unroll
                for (int n = 0; n < 2; ++n) acc[a][b][m][n] = (f32x4){0.f, 0.f, 0.f, 0.f};
    bf16x8 At[4][2], B0[2][2], B1[2][2];
    const char* cA = (const char*)g.A + (size_t)cur.pm * tstep; const char* cB = (const char*)g.Bt + (size_t)cur.pn * tstep;
    S.a_ready(cur);
    if constexpr (SP2) {
        PG8_STAGE(PG8_SB(0, 0), cB, voffB); PG8_STAGE(PG8_SB(0, 1), cB + hstep, voffB); PG8_STAGE(PG8_SA(0, 0), cA, voffA); PG8_STAGE(PG8_SA(0, 1), cA + hstep, voffA);
        if (wr == 1) PG8_BAR;
        PG8_WAIT_V(2); PG8_BAR;
        PG8_STAGE(PG8_SB(1, 0), cB + kstep, voffB); PG8_STAGE(PG8_SA(1, 0), cA + kstep, voffA); PG8_STAGE(PG8_SB(1, 1), cB + hstep + kstep, voffB);
        PG8_WAIT_V(6); PG8_BAR;
    } else {
        PG8_STAGE(PG8_SB(0, 0), cB, voffB); PG8_STAGE(PG8_SA(0, 0), cA, voffA); PG8_STAGE(PG8_SB(0, 1), cB + hstep, voffB); PG8_STAGE(PG8_SA(0, 1), cA + hstep, voffA);
        if (wr == 1) PG8_BAR;
        PG8_WAIT_V(4); PG8_BAR;
        PG8_STAGE(PG8_SB(1, 0), cB + kstep, voffB); PG8_STAGE(PG8_SA(1, 0), cA + kstep, voffA); PG8_STAGE(PG8_SB(1, 1), cB + hstep + kstep, voffB);
        PG8_WAIT_V(6); PG8_BAR;
    }
    for (;;) {
        const bool has_next = S.next(ui + 1, nxt);
        const char* nA = has_next ? (const char*)g.A + (size_t)nxt.pm * tstep : cA; const char* nB = has_next ? (const char*)g.Bt + (size_t)nxt.pn * tstep : cB;
        for (int t = 0; t < nt; t += 2) {
            const bool last = (t == nt - 2);
            const char* a1 = cA + (size_t)(t + 1) * kstep;
            const char* a2 = last ? nA : cA + (size_t)(t + 2) * kstep; const char* b2 = last ? nB : cB + (size_t)(t + 2) * kstep;
            const char* a3 = a2 + kstep; const char* b3 = b2 + kstep;
            if (last && has_next) S.a_ready(nxt);
            if constexpr (SP2) {
            PG8_LDB(B0, 0, 0); PG8_LDB(B1, 0, 1); PG8_SCHED; PG8_LDA(At, 0, 0); PG8_STAGE(PG8_SA(1, 1), a1 + hstep, voffA);
            PG8_WAIT_V(8); PG8_WAIT_L(0); PG8_BAR; PG8_MMA(0, 0, At, B0); PG8_MMA(0, 1, At, B1); PG8_BAR; PG8_SCHED;
            PG8_LDA(At, 0, 1); PG8_STAGE(PG8_SB(0, 0), b2, voffB); PG8_STAGE(PG8_SB(0, 1), b2 + hstep, voffB); PG8_STAGE(PG8_SA(0, 0), a2, voffA);
            PG8_WAIT_V(8); PG8_WAIT_L(0); PG8_BAR; PG8_MMA(1, 0, At, B0); PG8_MMA(1, 1, At, B1); PG8_BAR; PG8_SCHED;
            PG8_LDB(B0, 1, 0); PG8_LDB(B1, 1, 1); PG8_SCHED; PG8_LDA(At, 1, 0); PG8_STAGE(PG8_SA(0, 1), a2 + hstep, voffA);
            PG8_WAIT_V(8); PG8_WAIT_L(0); PG8_BAR; PG8_MMA(0, 0, At, B0); PG8_MMA(0, 1, At, B1); PG8_BAR; PG8_SCHED;
            PG8_LDA(At, 1, 1); PG8_STAGE(PG8_SB(1, 0), b3, voffB); PG8_STAGE(PG8_SB(1, 1), b3 + hstep, voffB); PG8_STAGE(PG8_SA(1, 0), a3, voffA);
            PG8_WAIT_V(8); PG8_WAIT_L(0); PG8_BAR; PG8_MMA(1, 0, At, B0); PG8_MMA(1, 1, At, B1); PG8_BAR; PG8_SCHED;
            } else {
            PG8_LDB(B0, 0, 0); PG8_SCHED; PG8_LDA(At, 0, 0); PG8_STAGE(PG8_SA(1, 1), a1 + hstep, voffA);
            PG8_WAIT_L(8); PG8_BAR; PG8_WAIT_L(0); PG8_MMA(0, 0, At, B0); PG8_BAR; PG8_SCHED;
            PG8_LDB(B1, 0, 1); PG8_STAGE(PG8_SB(0, 0), b2, voffB);
            PG8_BAR; PG8_WAIT_L(0); PG8_MMA(0, 1, At, B1); PG8_BAR;
            PG8_LDA(At, 0, 1); PG8_STAGE(PG8_SA(0, 0), a2, voffA);
            PG8_BAR; PG8_WAIT_L(0); PG8_MMA(1, 0, At, B0); PG8_BAR; PG8_SCHED;
            PG8_STAGE(PG8_SB(0, 1), b2 + hstep, voffB);
            PG8_WAIT_V(6); PG8_BAR; PG8_MMA(1, 1, At, B1); PG8_BAR;
            PG8_LDB(B0, 1, 0); PG8_SCHED; PG8_LDA(At, 1, 0); PG8_STAGE(PG8_SA(0, 1), a2 + hstep, voffA);
            PG8_WAIT_L(8); PG8_BAR; PG8_WAIT_L(0); PG8_MMA(0, 0, At, B0); PG8_BAR; PG8_SCHED;
            PG8_LDB(B1, 1, 1); PG8_STAGE(PG8_SB(1, 0), b3, voffB);
            PG8_BAR; PG8_WAIT_L(0); PG8_MMA(0, 1, At, B1); PG8_BAR;
            PG8_LDA(At, 1, 1); PG8_STAGE(PG8_SA(1, 0), a3, voffA);
            PG8_BAR; PG8_WAIT_L(0); PG8_MMA(1, 0, At, B0); PG8_BAR; PG8_SCHED;
            PG8_STAGE(PG8_SB(1, 1), b3 + hstep, voffB);
            PG8_WAIT_V(6); PG8_BAR; PG8_MMA(1, 1, At, B1); PG8_BAR;
            }
        }
        if constexpr (ALIGN_EPI) { if (wr == 0) PG8_BAR; }
        if constexpr (!Epi::AFTER_DRAIN) { E(acc, cur, wr, wc, fr, fq); S.done(cur); }
        if (!has_next) break;
#pragma unroll
        for (int a = 0; a < 2; ++a)
#pragma unroll
            for (int b = 0; b < 2; ++b)
#pragma unroll
                for (int m = 0; m < 4; ++m)
#pragma unroll
                    for (int n = 0; n < 2; ++n) acc[a][b][m][n] = (f32x4){0.f, 0.f, 0.f, 0.f};
        cur = nxt; cA = nA; cB = nB; ++ui;
        if constexpr (ALIGN_EPI) { if (wr == 1) PG8_BAR; }
    }
    PG8_WAIT_V(0);
    if constexpr (!ALIGN_EPI) { if (wr == 0) PG8_BAR; }
    PG8_BAR;
    if constexpr (Epi::AFTER_DRAIN) { E.fused(acc, cur, wr, wc, fr, fq, lds, wid, lane); S.done(cur); }
#undef PG8_SA
#undef PG8_SB
#undef PG8_STAGE
#undef PG8_LDA
#undef PG8_LDB
#undef PG8_MMA
#undef PG8_WAIT_V
#undef PG8_WAIT_L
#undef PG8_BAR
#undef PG8_SCHED
}
}
namespace att {
using bf16x8 = __attribute__((ext_vector_type(8))) short;
using s16x4  = __attribute__((ext_vector_type(4))) short;
using f32x16 = __attribute__((ext_vector_type(16))) float;
using u32x4  = __attribute__((ext_vector_type(4))) unsigned;
constexpr int NW = 8, QBLK = 32, KVBLK = 64, LD = 4096;
constexpr float THRL = 11.5f;
constexpr int SHM_V = KVBLK * 128 * 2, SHM_K = KVBLK * 128 * 2, SHM_ATTN = 2 * SHM_V + 2 * SHM_K + NW * 64 * 4;
#define KSWZ(row, colB) ((row) * 256 + ((colB) ^ (((row) & 7) << 4)))
#define SBAR() __builtin_amdgcn_sched_barrier(0)
__device__ __forceinline__ int crow(int r, int hi) { return (r & 3) + 8 * (r >> 2) + 4 * hi; }
__device__ __forceinline__ unsigned cvtpk(float lo, float hi) { return pg8::cvt_pk_bf16(lo, hi); }

__device__ __forceinline__ void partialSM(f32x16& p0, f32x16& p1, float& m_reg, float& mn, float& alpha) {
  float pmax = p0[0];
#pragma unroll
  for (int r = 1; r < 16; ++r) pmax = fmaxf(pmax, p0[r]);
#pragma unroll
  for (int r = 0; r < 16; ++r) pmax = fmaxf(pmax, p1[r]);
  { auto rr = __builtin_amdgcn_permlane32_swap(__float_as_uint(pmax), __float_as_uint(pmax), false, false);
    pmax = fmaxf(__uint_as_float(rr[0]), __uint_as_float(rr[1])); }
  if (__builtin_expect(__all(pmax - m_reg <= THRL), 1)) { mn = m_reg; alpha = 1.f; }
  else { mn = fmaxf(m_reg, pmax); alpha = __builtin_amdgcn_exp2f(m_reg - mn); m_reg = mn; }
#pragma unroll
  for (int r = 0; r < 16; ++r) p0[r] = p0[r] - mn;
#pragma unroll
  for (int r = 0; r < 16; ++r) p1[r] = p1[r] - mn;
#pragma unroll
  for (int r = 0; r < 16; ++r) p0[r] = __builtin_amdgcn_exp2f(p0[r]);
}
__device__ __forceinline__ void finishSM(f32x16& p0, f32x16& p1, float alpha, float& l_reg, bf16x8& pa0, bf16x8& pa1, bf16x8& pa2, bf16x8& pa3) {
#pragma unroll
  for (int r = 0; r < 16; ++r) p1[r] = __builtin_amdgcn_exp2f(p1[r]);
  float ps = 0;
#pragma unroll
  for (int r = 0; r < 16; ++r) ps += p0[r];
#pragma unroll
  for (int r = 0; r < 16; ++r) ps += p1[r];
  { auto rr = __builtin_amdgcn_permlane32_swap(__float_as_uint(ps), __float_as_uint(ps), false, false);
    ps = __uint_as_float(rr[0]) + __uint_as_float(rr[1]); }
  l_reg = l_reg * alpha + ps;
#define PK4(P, BASE, OUT) do { unsigned a0 = cvtpk(P[BASE + 0], P[BASE + 1]), a1 = cvtpk(P[BASE + 2], P[BASE + 3]);   \
    unsigned b0 = cvtpk(P[BASE + 4], P[BASE + 5]), b1 = cvtpk(P[BASE + 6], P[BASE + 7]);                              \
    auto r0 = __builtin_amdgcn_permlane32_swap(a0, b0, false, false); auto r1 = __builtin_amdgcn_permlane32_swap(a1, b1, false, false); \
    u32x4 w = {r0[0], r1[0], r0[1], r1[1]}; OUT = *reinterpret_cast<bf16x8*>(&w); } while (0)
  PK4(p0, 0, pa0); PK4(p0, 8, pa1); PK4(p1, 0, pa2); PK4(p1, 8, pa3);
#undef PK4
}
__device__ __forceinline__ void qkt(f32x16& p0, f32x16& p1, const char* Ks, const bf16x8* qr, int r32, int hi, int sub) {
  p0 = f32x16{}; p1 = f32x16{};
#pragma unroll
  for (int d0 = 0; d0 < 4; ++d0) { int cb = ((sub * 4 + d0) * 16 + hi * 8) * 2;
    bf16x8 b0 = *reinterpret_cast<const bf16x8*>(Ks + KSWZ(r32, cb));
    bf16x8 b1 = *reinterpret_cast<const bf16x8*>(Ks + KSWZ(32 + r32, cb));
    p0 = __builtin_amdgcn_mfma_f32_32x32x16_bf16(b0, qr[d0], p0, 0, 0, 0);
    p1 = __builtin_amdgcn_mfma_f32_32x32x16_bf16(b1, qr[d0], p1, 0, 0, 0); }
}
__device__ __forceinline__ int v_st(int k, int c) { const int kk = (k & ~0xC) | ((k & 4) << 1) | ((k & 8) >> 1); return ((kk >> 3) * 4 + (c >> 5)) * 512 + ((kk & 7) * 32 + (c & 31)) * 2; }
__device__ __forceinline__ int v_rd_base(int lane) { return ((lane & 3) << 3) | (((lane >> 2) & 3) << 6) | (((lane >> 4) & 1) << 5) | (((lane >> 5) & 1) << 8); }
constexpr int v_rd_off(int d0, int ks, int half) { return d0 * 512 + ks * 4096 + half * 2048; }
template <int OFF> __device__ __forceinline__ s16x4 tr_read(int vb) {
  s16x4 r; asm volatile("ds_read_b64_tr_b16 %0, %1 offset:%2" : "=&v"(r) : "v"(vb), "i"(OFF) : "memory"); return r;
}
template <int D0> __device__ __forceinline__ void pv_one(f32x16& od, int vb, bf16x8 pa0, bf16x8 pa1, bf16x8 pa2, bf16x8 pa3) {
  const s16x4 l0 = tr_read<v_rd_off(D0, 0, 0)>(vb), h0 = tr_read<v_rd_off(D0, 0, 1)>(vb), l1 = tr_read<v_rd_off(D0, 1, 0)>(vb), h1 = tr_read<v_rd_off(D0, 1, 1)>(vb);
  const s16x4 l2 = tr_read<v_rd_off(D0, 2, 0)>(vb), h2 = tr_read<v_rd_off(D0, 2, 1)>(vb), l3 = tr_read<v_rd_off(D0, 3, 0)>(vb), h3 = tr_read<v_rd_off(D0, 3, 1)>(vb);
  asm volatile("s_waitcnt lgkmcnt(0)" ::: "memory"); SBAR();
#define PK(L, H) (bf16x8){L[0], L[1], L[2], L[3], H[0], H[1], H[2], H[3]}
  od = __builtin_amdgcn_mfma_f32_32x32x16_bf16(pa0, PK(l0, h0), od, 0, 0, 0);
  od = __builtin_amdgcn_mfma_f32_32x32x16_bf16(pa1, PK(l1, h1), od, 0, 0, 0);
  od = __builtin_amdgcn_mfma_f32_32x32x16_bf16(pa2, PK(l2, h2), od, 0, 0, 0);
  od = __builtin_amdgcn_mfma_f32_32x32x16_bf16(pa3, PK(l3, h3), od, 0, 0, 0);
#undef PK
}
__device__ __forceinline__ void pv_d0(f32x16* o, int vb, bf16x8 pa0, bf16x8 pa1, bf16x8 pa2, bf16x8 pa3) {
  pv_one<0>(o[0], vb, pa0, pa1, pa2, pa3); pv_one<1>(o[1], vb, pa0, pa1, pa2, pa3); pv_one<2>(o[2], vb, pa0, pa1, pa2, pa3); pv_one<3>(o[3], vb, pa0, pa1, pa2, pa3);
}

__device__ __forceinline__ void attn_unit(const unsigned short* __restrict__ Qb, const unsigned short* __restrict__ Kh, const unsigned short* __restrict__ Vh,
                                          unsigned short* __restrict__ Ob, int seq, char* lds, float lam, float post, const float* __restrict__ subln) {
  int tid_l = threadIdx.x; asm volatile("" : "+v"(tid_l));
  const int tid = tid_l, wid = tid >> 6, lane = tid & 63, r32 = lane & 31, hi = lane >> 5;
  const int sub = __builtin_amdgcn_readfirstlane(wid >> 2), wq = __builtin_amdgcn_readfirstlane(wid & 3);
  char* V_lds = lds; char* K_lds = lds + 2 * SHM_V;
  float* ws = (float*)(lds + 2 * SHM_V + 2 * SHM_K) + wid * 64; float* li_l = ws; float* al_l = ws + 32;
  float m_reg = -1e30f, l_reg = 0; f32x16 o[4] = {}; bf16x8 qr[4];
  const unsigned short* Qw = Qb + (long)(wq * QBLK + r32) * LD + sub * 64 + hi * 8;
#pragma unroll
  for (int d0 = 0; d0 < 4; ++d0) qr[d0] = *reinterpret_cast<const bf16x8*>(Qw + d0 * 16);
  const int sr = tid >> 4, sc = (tid & 15) * 8, vst0 = v_st(sr, sc), vst1 = v_st(32 + sr, sc);
  const int vb0 = (int)(uintptr_t)V_lds + v_rd_base(lane);
  struct { bf16x8 vs0, vs1, ks0, ks1; } sr_[2];
#define SLOAD(i, k0) do { sr_[i].vs0 = *reinterpret_cast<const bf16x8*>(&Vh[(long)((k0) + sr) * LD + sc]); sr_[i].vs1 = *reinterpret_cast<const bf16x8*>(&Vh[(long)((k0) + 32 + sr) * LD + sc]); \
    sr_[i].ks0 = *reinterpret_cast<const bf16x8*>(&Kh[(long)((k0) + sr) * LD + sc]); sr_[i].ks1 = *reinterpret_cast<const bf16x8*>(&Kh[(long)((k0) + 32 + sr) * LD + sc]); } while (0)
#define SWRITE(b, i) do { *(bf16x8*)(V_lds + (b) * SHM_V + vst0) = sr_[i].vs0;          \
    *(bf16x8*)(V_lds + (b) * SHM_V + vst1) = sr_[i].vs1; int kc = sc * 2;               \
    *(bf16x8*)(K_lds + (b) * SHM_K + KSWZ(sr, kc)) = sr_[i].ks0;                       \
    *(bf16x8*)(K_lds + (b) * SHM_K + KSWZ(32 + sr, kc)) = sr_[i].ks1; } while (0)
#define SWAIT() asm volatile("s_waitcnt vmcnt(4)" ::: "memory")
#define RESC(a) do { if (__any((a) < 1.f)) { if (hi == 0) al_l[r32] = (a); asm volatile("s_waitcnt lgkmcnt(0)" ::: "memory"); \
    _Pragma("unroll") for (int d = 0; d < 4; ++d) _Pragma("unroll") for (int r = 0; r < 16; ++r) o[d][r] *= al_l[crow(r, hi)]; } } while (0)
  f32x16 pA0, pA1, pB0, pB1; float mnA, mnB, alA, alB; bf16x8 pa0, pa1, pa2, pa3; const int NT = seq / KVBLK;
  constexpr int SE = 0, SO = 1;
  SLOAD(SE, 0); asm volatile("s_waitcnt vmcnt(0)" ::: "memory"); SWRITE(0, SE); __syncthreads();
  qkt(pA0, pA1, K_lds, qr, r32, hi, sub); partialSM(pA0, pA1, m_reg, mnA, alA);
  SLOAD(SO, KVBLK); if (2 < NT) SLOAD(SE, 2 * KVBLK);
  SWAIT(); SWRITE(1, SO); __syncthreads();
  for (int j = 1; j + 1 < NT; j += 2) {
    SBAR(); qkt(pB0, pB1, K_lds + SHM_K, qr, r32, hi, sub);
    finishSM(pA0, pA1, alA, l_reg, pa0, pa1, pa2, pa3); SBAR();
    SLOAD(SO, (j + 2) * KVBLK); SBAR();
    pv_d0(o, vb0, pa0, pa1, pa2, pa3); partialSM(pB0, pB1, m_reg, mnB, alB);
    __syncthreads(); SWAIT(); SWRITE(0, SE);
    RESC(alB); __syncthreads();
    SBAR(); qkt(pA0, pA1, K_lds, qr, r32, hi, sub);
    finishSM(pB0, pB1, alB, l_reg, pa0, pa1, pa2, pa3); SBAR();
    if (j + 3 < NT) SLOAD(SE, (j + 3) * KVBLK); SBAR();
    pv_d0(o, vb0 + (int)SHM_V, pa0, pa1, pa2, pa3); partialSM(pA0, pA1, m_reg, mnA, alA);
    __syncthreads(); SWAIT(); SWRITE(1, SO);
    RESC(alA); __syncthreads();
  }
  SBAR(); qkt(pB0, pB1, K_lds + SHM_K, qr, r32, hi, sub);
  finishSM(pA0, pA1, alA, l_reg, pa0, pa1, pa2, pa3); SBAR();
  pv_d0(o, vb0, pa0, pa1, pa2, pa3); partialSM(pB0, pB1, m_reg, mnB, alB);
  __syncthreads(); RESC(alB);
  finishSM(pB0, pB1, alB, l_reg, pa0, pa1, pa2, pa3); SBAR();
  pv_d0(o, vb0 + (int)SHM_V, pa0, pa1, pa2, pa3);
  if (hi == 0) li_l[r32] = l_reg; asm volatile("s_waitcnt lgkmcnt(0)" ::: "memory");
  float rli[16];
#pragma unroll
  for (int r = 0; r < 16; ++r) rli[r] = __builtin_amdgcn_rcpf(li_l[crow(r, hi)]);
  asm volatile("s_waitcnt vmcnt(0)" ::: "memory");
  __syncthreads();
  float* X = (float*)lds;
  if (sub == 1) {
#pragma unroll
    for (int r = 0; r < 16; ++r) { const int orow = crow(r, hi);
#pragma unroll
      for (int d0 = 0; d0 < 4; ++d0) X[(wq * 32 + orow) * 128 + d0 * 32 + r32] = o[d0][r] * rli[r]; }
  }
  __syncthreads();
  if (sub == 0) {
    float sw[4];
#pragma unroll
    for (int d0 = 0; d0 < 4; ++d0) sw[d0] = subln[d0 * 32 + r32] * post;
    unsigned short* Ow = Ob + (long)(wq * QBLK) * 1024;
#pragma unroll
    for (int r = 0; r < 16; ++r) { const int orow = crow(r, hi); float ss = 0.f; float v[4];
#pragma unroll
      for (int d0 = 0; d0 < 4; ++d0) { v[d0] = o[d0][r] * rli[r] - lam * X[(wq * 32 + orow) * 128 + d0 * 32 + r32]; ss += v[d0] * v[d0]; }
      ss += __shfl_xor(ss, 1); ss += __shfl_xor(ss, 2); ss += __shfl_xor(ss, 4); ss += __shfl_xor(ss, 8); ss += __shfl_xor(ss, 16);
      const float rs = __builtin_amdgcn_rsqf(ss * (1.0f / 128.0f) + 1e-5f);
#pragma unroll
      for (int d0 = 0; d0 < 4; ++d0) { const float ov = v[d0] * rs * sw[d0]; Ow[(long)orow * 1024 + d0 * 32 + r32] = (unsigned short)(cvtpk(ov, ov) & 0xffffu); } }
  }
  __syncthreads();
#undef SLOAD
#undef SWRITE
#undef SWAIT
#undef RESC
}
#undef SBAR
#undef KSWZ
}

constexpr int DM = 1024, MTOK = 49152, NPROMPT = 16384, TP = 4096, TS = 2048, NCB = 20, FFH = 2816, INC = 4096;
constexpr size_t MiB = 1u << 20;
constexpr size_t WS_WIN = 0, WS_WOUT = 8 * MiB, WS_W1 = 10 * MiB, WS_W2 = 21 * MiB;
constexpr size_t WS_MOD = 27 * MiB;
constexpr size_t WS_CTR = 27 * MiB + 983040;
constexpr size_t WS_BAR = 27 * MiB + 983040 + 4096;
constexpr size_t WS_COS = 28 * MiB, WS_SIN = 28 * MiB + 512 * 1024;
constexpr size_t WS_BUFA = 29 * MiB;
constexpr size_t WS_QKV = 125 * MiB;
constexpr size_t WS_Y = WS_QKV + 264 * MiB;
constexpr size_t WS_END = WS_QKV + 384 * MiB;
constexpr int C_Q = 0, C_UF = 512, C_UB = 1024, C_V = 1536, C_G = 2048, C_DQ = 2560, C_DK = 3072, C_DV = 3584;

typedef unsigned short bf16;
typedef unsigned v4u __attribute__((ext_vector_type(4)));
typedef unsigned v2u __attribute__((ext_vector_type(2)));
typedef float f32x4 __attribute__((ext_vector_type(4)));
typedef short bf16x8 __attribute__((ext_vector_type(8)));
typedef short bf16x4 __attribute__((ext_vector_type(4)));
#define LAS __attribute__((address_space(3)))
__device__ __forceinline__ unsigned pk2(float lo, float hi) { return pg8::cvt_pk_bf16(lo, hi); }
__device__ __forceinline__ float bf2f(unsigned short h) { return __uint_as_float((unsigned)h << 16); }
__device__ __forceinline__ float bflo(unsigned w) { return __uint_as_float(w << 16); }
__device__ __forceinline__ float bfhi(unsigned w) { return __uint_as_float(w & 0xffff0000u); }
__device__ __forceinline__ float wave_sum(float v) {
#pragma unroll
    for (int o = 1; o < 64; o <<= 1) v += __shfl_xor(v, o);
    return v;
}

struct Args { const float* in[22]; float* out; unsigned char* ws; int ph_lo, ph_hi, xr, pad; };

namespace hg {
constexpr int RS = 272;
constexpr int OFF_QT = 0, OFF_KD = 32 * RS, OFF_KET = 2 * 32 * RS, OFF_VT = OFF_KET + 128 * 64, OFF_D = OFF_VT + 128 * 64, BUF = OFF_D + 512;
__device__ __forceinline__ void chain(const Args& a, int layer, int cid, char* lds) {
    int tid_l = threadIdx.x; asm volatile("" : "+v"(tid_l));
    const int tid = tid_l, lane = tid & 63, w = __builtin_amdgcn_readfirstlane(tid >> 6), kc = lane & 15, tg = lane >> 4;
    int cb, hd, dir, T, row0;
    if (cid < 32) { cb = cid >> 3; hd = (cid >> 1) & 3; dir = cid & 1; T = TP; row0 = cb * TP; }
    else { const int c2 = cid - 32; cb = 4 + (c2 >> 3); hd = (c2 >> 1) & 3; dir = c2 & 1; T = TS; row0 = NPROMPT + (cb - 4) * TS; }
    const int k = 16 * w + kc;
    float lb = 0.f;
    if (layer == 1) { const float a0 = a.in[11][(dir * 2 + 0) * 512 + 128 * hd + k], a1 = a.in[11][(dir * 2 + 1) * 512 + 128 * hd + k]; lb = 1.0f / (1.0f + __expf(a0 - a1)); }
    const float lbf = fmaxf(lb, 1e-30f), oml = 1.0f - lb;
    bf16* QKV = (bf16*)(a.ws + WS_QKV);
    const bf16* qp = QKV + C_Q + 128 * hd; const bf16* up = QKV + C_UF + 512 * dir + 128 * hd; const bf16* vp = QKV + C_V + 128 * hd;
    bf16* op = QKV + C_UF + 512 * dir + 128 * hd;
    const int c = lane & 15, g = lane >> 4;
    unsigned toff[8], ooff[8];
#pragma unroll
    for (int j = 0; j < 8; ++j) { const int tau = 8 * tg + j; toff[j] = (unsigned)((dir ? 31 - tau : tau) * INC + k);
        const int to = 16 * (j >> 2) + 4 * g + (j & 3); ooff[j] = (unsigned)((dir ? 31 - to : to) * INC + 16 * w + c); }
    const int NS = T / 32;
    unsigned rq[2][8], ru[2][8], rv[2][8];
#define HG_RB(i) ((size_t)(row0 + (dir ? (T - 32 - 32 * (i)) : 32 * (i))) * INC)
#define HG_LOAD(s_, i) do { const bf16* q_ = qp + HG_RB(i); const bf16* u_ = up + HG_RB(i); const bf16* v_ = vp + HG_RB(i); _Pragma("unroll") for (int j = 0; j < 8; ++j) { rq[s_][j] = q_[toff[j]]; ru[s_][j] = u_[toff[j]]; rv[s_][j] = v_[toff[j]]; } } while (0)
#define HG_PREP(s_, bufp) do { char* B_ = (bufp); float kk[8], pl[8]; \
          \
        _Pragma("unroll") for (int j = 0; j < 8; ++j) { asm volatile("" : "+v"(rq[s_][j]), "+v"(ru[s_][j]), "+v"(rv[s_][j])); } \
        _Pragma("unroll") for (int j = 0; j < 8; ++j) { const float uu = __uint_as_float(ru[s_][j] << 16); kk[j] = oml * uu; const float f = fmaxf(lbf + (oml - kk[j]), 9.765625e-4f); pl[j] = (j == 0) ? f : pl[j - 1] * f; } \
        const float G = pl[7]; float s1 = __shfl_up(G, 16); if (tg < 1) s1 = 1.f; const float i2 = G * s1; float s2 = __shfl_up(i2, 32); if (tg < 2) s2 = 1.f; const float incl = i2 * s2; \
        float E = __shfl_up(incl, 16); if (tg == 0) E = 1.f; const float Pend = __shfl(incl, 48 + kc); float ke[8]; \
        _Pragma("unroll") for (int j = 0; j < 8; ++j) { const float P = fmaxf(E * pl[j], 1e-30f); const float rP = __builtin_amdgcn_rcpf(P); const float qt = __uint_as_float(rq[s_][j] << 16) * P; const float kd = kk[j] * rP; ke[j] = kd * Pend; \
            *(unsigned short*)(B_ + OFF_QT + (8 * tg + j) * RS + k * 2) = (unsigned short)(pk2(qt, qt) & 0xffffu); *(unsigned short*)(B_ + OFF_KD + (8 * tg + j) * RS + k * 2) = (unsigned short)(pk2(kd, kd) & 0xffffu); } \
        v4u kw; kw.x = pk2(ke[0], ke[1]); kw.y = pk2(ke[2], ke[3]); kw.z = pk2(ke[4], ke[5]); kw.w = pk2(ke[6], ke[7]); *(v4u*)(B_ + OFF_KET + k * 64 + tg * 16) = kw; \
        v4u vw; vw.x = rv[s_][0] | (rv[s_][1] << 16); vw.y = rv[s_][2] | (rv[s_][3] << 16); vw.z = rv[s_][4] | (rv[s_][5] << 16); vw.w = rv[s_][6] | (rv[s_][7] << 16); \
        *(v4u*)(B_ + OFF_VT + k * 64 + tg * 16) = vw; \
        if (tg == 0) *(float*)(B_ + OFF_D + k * 4) = Pend; } while (0)
    f32x4 S[8];
#pragma unroll
    for (int i = 0; i < 8; ++i) S[i] = (f32x4){0.f, 0.f, 0.f, 0.f};
    const f32x4 z4 = (f32x4){0.f, 0.f, 0.f, 0.f};
    HG_LOAD(0, 0); HG_PREP(0, lds); HG_LOAD(1, 1);
    __syncthreads();
    const bool prep_first = (w < 4);
    for (int i2_ = 0; i2_ < NS; i2_ += 2) {
#pragma unroll
      for (int s = 0; s < 2; ++s) {
        const int i = i2_ + s;
        char* cur = lds + s * BUF; char* nxt = lds + (s ^ 1) * BUF;
        if (prep_first) { if (i + 1 < NS) { HG_PREP(s ^ 1, nxt); if (i + 2 < NS) HG_LOAD(s, i + 2); } }
        f32x4 st00 = z4, st01 = z4, st11 = z4;
        { bf16x8 kd0[4], qt0[4], qt1[4], kd1[4];
#pragma unroll
          for (int ks = 0; ks < 4; ++ks) { kd0[ks] = *(const bf16x8*)(cur + OFF_KD + c * RS + ks * 64 + g * 16); qt0[ks] = *(const bf16x8*)(cur + OFF_QT + c * RS + ks * 64 + g * 16); }
#pragma unroll
          for (int ks = 0; ks < 4; ++ks) st00 = __builtin_amdgcn_mfma_f32_16x16x32_bf16(kd0[ks], qt0[ks], st00, 0, 0, 0);
#pragma unroll
          for (int ks = 0; ks < 4; ++ks) qt1[ks] = *(const bf16x8*)(cur + OFF_QT + (16 + c) * RS + ks * 64 + g * 16);
#pragma unroll
          for (int ks = 0; ks < 4; ++ks) st01 = __builtin_amdgcn_mfma_f32_16x16x32_bf16(kd0[ks], qt1[ks], st01, 0, 0, 0);
#pragma unroll
          for (int ks = 0; ks < 4; ++ks) kd1[ks] = *(const bf16x8*)(cur + OFF_KD + (16 + c) * RS + ks * 64 + g * 16);
#pragma unroll
          for (int ks = 0; ks < 4; ++ks) st11 = __builtin_amdgcn_mfma_f32_16x16x32_bf16(kd1[ks], qt1[ks], st11, 0, 0, 0); }
#pragma unroll
        for (int r = 0; r < 4; ++r) if (4 * g + r > c) { st00[r] = 0.f; st11[r] = 0.f; }
        v2u pw; pw.x = pk2(st00[0], st00[1]); pw.y = pk2(st00[2], st00[3]); const bf16x4 pt00 = __builtin_bit_cast(bf16x4, pw);
        pw.x = pk2(st01[0], st01[1]); pw.y = pk2(st01[2], st01[3]); const bf16x4 pt01 = __builtin_bit_cast(bf16x4, pw);
        pw.x = pk2(st11[0], st11[1]); pw.y = pk2(st11[2], st11[3]); const bf16x4 pt11 = __builtin_bit_cast(bf16x4, pw);
        const bf16x4 vt0 = *(const bf16x4*)(cur + OFF_VT + (16 * w + c) * 64 + g * 8);
        const bf16x4 vt1 = *(const bf16x4*)(cur + OFF_VT + (16 * w + c) * 64 + 32 + g * 8);
        f32x4 o0 = __builtin_amdgcn_mfma_f32_16x16x16bf16_1k(pt00, vt0, z4, 0, 0, 0);
        f32x4 o1 = __builtin_amdgcn_mfma_f32_16x16x16bf16_1k(pt01, vt0, z4, 0, 0, 0);
        o1 = __builtin_amdgcn_mfma_f32_16x16x16bf16_1k(pt11, vt1, o1, 0, 0, 0);
#pragma unroll
        for (int kt = 0; kt < 8; ++kt) { const bf16x4 a0 = *(const bf16x4*)(cur + OFF_QT + c * RS + kt * 32 + g * 8); const bf16x4 a1 = *(const bf16x4*)(cur + OFF_QT + (16 + c) * RS + kt * 32 + g * 8);
            v2u sw; sw.x = pk2(S[kt][0], S[kt][1]); sw.y = pk2(S[kt][2], S[kt][3]); const bf16x4 sb = __builtin_bit_cast(bf16x4, sw);
            o0 = __builtin_amdgcn_mfma_f32_16x16x16bf16_1k(a0, sb, o0, 0, 0, 0); o1 = __builtin_amdgcn_mfma_f32_16x16x16bf16_1k(a1, sb, o1, 0, 0, 0); }
        { bf16* o_ = op + HG_RB(i);
#pragma unroll
          for (int r = 0; r < 4; ++r) { const unsigned w0 = pk2(o0[r], o0[r]), w1 = pk2(o1[r], o1[r]); o_[ooff[r]] = (unsigned short)(w0 & 0xffffu); o_[ooff[4 + r]] = (unsigned short)(w1 & 0xffffu); } }
        { const bf16x8 vb = *(const bf16x8*)(cur + OFF_VT + (16 * w + c) * 64 + g * 16);
#pragma unroll
          for (int kt = 0; kt < 8; ++kt) { const f32x4 d4 = *(const f32x4*)(cur + OFF_D + (16 * kt + 4 * g) * 4); const bf16x8 af = *(const bf16x8*)(cur + OFF_KET + (16 * kt + c) * 64 + g * 16);
              S[kt] = __builtin_amdgcn_mfma_f32_16x16x32_bf16(af, vb, S[kt] * d4, 0, 0, 0); } }
        if (!prep_first) { if (i + 1 < NS) { HG_PREP(s ^ 1, nxt); if (i + 2 < NS) HG_LOAD(s, i + 2); } }
        __syncthreads();
      }
    }
#undef HG_RB
#undef HG_LOAD
#undef HG_PREP
}
__device__ __forceinline__ void combine_rows(const Args& a, int layer, int gw, int NGW, int lane) {
    const bf16* QKV = (const bf16*)(a.ws + WS_QKV); bf16* MIX = (bf16*)(a.ws + WS_BUFA);
    const float* gn = a.in[12] + layer * 128 + (lane & 15) * 8; float gw8[8];
#pragma unroll
    for (int e = 0; e < 8; ++e) gw8[e] = gn[e];
    for (int m = gw; m < MTOK; m += NGW) {
        const bf16* rowp = QKV + (size_t)m * INC + lane * 8;
        const v4u f = *(const v4u*)(rowp + C_UF), b = *(const v4u*)(rowp + C_UB), gg = *(const v4u*)(rowp + C_G);
        float o[8]; float ss = 0.f;
#pragma unroll
        for (int e = 0; e < 4; ++e) { o[2 * e] = bflo(f[e]) + bflo(b[e]); o[2 * e + 1] = bfhi(f[e]) + bfhi(b[e]); ss += o[2 * e] * o[2 * e] + o[2 * e + 1] * o[2 * e + 1]; }
        ss += __shfl_xor(ss, 1); ss += __shfl_xor(ss, 2); ss += __shfl_xor(ss, 4); ss += __shfl_xor(ss, 8);
        const float rs = __builtin_amdgcn_rsqf(ss * (1.0f / 128.0f) + 1e-6f);
        v4u w;
#pragma unroll
        for (int e = 0; e < 4; ++e) w[e] = pk2(o[2 * e] * rs * gw8[2 * e] * pg8::silu_f(bflo(gg[e])), o[2 * e + 1] * rs * gw8[2 * e + 1] * pg8::silu_f(bfhi(gg[e])));
        *(v4u*)(MIX + (size_t)m * DM + lane * 8) = w;
    }
}
}

__device__ __forceinline__ void rowpass(const Args& a, int layer, int which, int gw, int NGW, int lane) {
    float* xo = a.out; bf16* XR = (bf16*)(a.ws + WS_END); bf16* H = (bf16*)(a.ws + WS_BUFA); const bf16* Y = (const bf16*)(a.ws + WS_Y); const float* MOD = (const float*)(a.ws + WS_MOD);
    const int c0 = 4 * lane;
    const bool from_in = (which == 0 || (which == 1 && layer == 0));
    const bool src16 = a.xr && !from_in, dst16 = a.xr && !(which == 2 && layer == 1);
    f32x4 wpost[4], wpre[4];
    const float* wpostp = (which == 1) ? a.in[7] + layer * DM : a.in[9] + layer * DM;
    const int hl = (which == 2) ? layer + 1 : layer;
    const float* wprep = (which == 1) ? a.in[8] + layer * DM : a.in[6] + (hl < 2 ? hl : 0) * DM;
    const bool do_h = !(which == 2 && layer == 1);
#pragma unroll
    for (int j = 0; j < 4; ++j) { wpost[j] = *(const f32x4*)(wpostp + c0 + 256 * j); wpre[j] = *(const f32x4*)(wprep + c0 + 256 * j); }
    const int rpw = ((MTOK + NGW - 1) / NGW + 7) & ~7; const int mbeg = gw * rpw, mend = (mbeg + rpw < MTOK) ? mbeg + rpw : MTOK;
    f32x4 gt[4], sh[4], scl[4]; int cbl = -1;
    constexpr int RG = 4;
    for (int m0 = mbeg; m0 < mend; m0 += RG) {
        const int cb = m0 < NPROMPT ? (m0 >> 12) : 4 + ((m0 - NPROMPT) >> 11);
        if (cb != cbl) { cbl = cb;
            const float* modp = MOD + (size_t)(layer * NCB + cb) * 6144 + (which == 1 ? 2048 : 5120);
            const float* modh = MOD + (size_t)((hl < 2 ? hl : 0) * NCB + cb) * 6144 + (which == 1 ? 3072 : 0);
#pragma unroll
            for (int j = 0; j < 4; ++j) { gt[j] = *(const f32x4*)(modp + c0 + 256 * j); sh[j] = *(const f32x4*)(modh + c0 + 256 * j); scl[j] = *(const f32x4*)(modh + 1024 + c0 + 256 * j) + 1.0f; } }
        f32x4 x[RG][4]; v2u yr[RG][4]; int mq[RG];
#pragma unroll
        for (int q = 0; q < RG; ++q) { const int m = (m0 + q < mend) ? m0 + q : m0; mq[q] = m;
            if (src16) {
#pragma unroll
                for (int j = 0; j < 4; ++j) { const v2u xw = *(const v2u*)(XR + (size_t)m * DM + c0 + 256 * j); x[q][j] = (f32x4){bflo(xw.x), bfhi(xw.x), bflo(xw.y), bfhi(xw.y)}; }
            } else {
                const float* xin = from_in ? (m < NPROMPT ? a.in[0] + (size_t)m * DM : a.in[1] + (size_t)(m - NPROMPT) * DM) : xo + (size_t)m * DM;
#pragma unroll
                for (int j = 0; j < 4; ++j) x[q][j] = *(const f32x4*)(xin + c0 + 256 * j);
            }
            if (which != 0) {
#pragma unroll
                for (int j = 0; j < 4; ++j) yr[q][j] = *(const v2u*)(Y + (size_t)m * DM + c0 + 256 * j); } }
        if (which != 0) {
            float ss[RG]; f32x4 y[RG][4];
#pragma unroll
            for (int q = 0; q < RG; ++q) { ss[q] = 0.f;
#pragma unroll
                for (int j = 0; j < 4; ++j) { const v2u yw = yr[q][j]; y[q][j] = (f32x4){bflo(yw.x), bfhi(yw.x), bflo(yw.y), bfhi(yw.y)};
                    ss[q] += (y[q][j].x * y[q][j].x + y[q][j].y * y[q][j].y) + (y[q][j].z * y[q][j].z + y[q][j].w * y[q][j].w); } }
#pragma unroll
            for (int o = 1; o < 64; o <<= 1) {
#pragma unroll
                for (int q = 0; q < RG; ++q) ss[q] += __shfl_xor(ss[q], o); }
#pragma unroll
            for (int q = 0; q < RG; ++q) { const float r = __builtin_amdgcn_rsqf(ss[q] * (1.0f / DM) + 1e-6f);
#pragma unroll
                for (int j = 0; j < 4; ++j) { x[q][j] = x[q][j] + gt[j] * (y[q][j] * r * wpost[j]);
                    if (dst16) { v2u w; w.x = pk2(x[q][j].x, x[q][j].y); w.y = pk2(x[q][j].z, x[q][j].w); *(v2u*)(XR + (size_t)mq[q] * DM + c0 + 256 * j) = w; }
                    else *(f32x4*)(xo + (size_t)mq[q] * DM + c0 + 256 * j) = x[q][j]; } }
        }
        if (do_h) {
            float ss[RG];
#pragma unroll
            for (int q = 0; q < RG; ++q) { ss[q] = 0.f;
#pragma unroll
                for (int j = 0; j < 4; ++j) ss[q] += (x[q][j].x * x[q][j].x + x[q][j].y * x[q][j].y) + (x[q][j].z * x[q][j].z + x[q][j].w * x[q][j].w); }
#pragma unroll
            for (int o = 1; o < 64; o <<= 1) {
#pragma unroll
                for (int q = 0; q < RG; ++q) ss[q] += __shfl_xor(ss[q], o); }
#pragma unroll
            for (int q = 0; q < RG; ++q) { const float r = __builtin_amdgcn_rsqf(ss[q] * (1.0f / DM) + 1e-6f);
#pragma unroll
                for (int j = 0; j < 4; ++j) { const f32x4 h = x[q][j] * r * wpre[j] * scl[j] + sh[j]; v2u w; w.x = pk2(h.x, h.y); w.y = pk2(h.z, h.w); *(v2u*)(H + (size_t)mq[q] * DM + c0 + 256 * j) = w; } }
        }
    }
}

__device__ __forceinline__ void transpose_item(const float* W, int K, int N, bf16* WT, int dn0, int sn0, int k0, LAS float* scr, int lane) {
#pragma unroll 8
    for (int i = 0; i < 32; ++i) { const int kk = 2 * i + (lane >> 5); scr[kk * 33 + (lane & 31)] = W[(size_t)(k0 + kk) * N + sn0 + (lane & 31)]; }
    asm volatile("s_waitcnt lgkmcnt(0)" ::: "memory");
    const int c = lane & 7;
#pragma unroll
    for (int j = 0; j < 4; ++j) { const int n = (lane >> 3) + 8 * j; const LAS float* s = scr + (8 * c) * 33 + n;
        v4u o; o.x = pk2(s[0 * 33], s[1 * 33]); o.y = pk2(s[2 * 33], s[3 * 33]); o.z = pk2(s[4 * 33], s[5 * 33]); o.w = pk2(s[6 * 33], s[7 * 33]);
        *(v4u*)(WT + (size_t)(dn0 + n) * K + k0 + 8 * c) = o; }
    asm volatile("s_waitcnt lgkmcnt(0)" ::: "memory");
}
__device__ __forceinline__ void convert_weights(const Args& a, int layer, LAS unsigned char* lds, int gw, int NGW, int wave, int lane) {
    LAS float* scr = (LAS float*)(lds + wave * 16384);
    constexpr int I_IN = 16 * 128, I_OUT = 16 * 32, I_1 = 16 * 176, I_2 = 44 * 32, NITEMS = I_IN + I_OUT + I_1 + I_2;
    bf16* WinT = (bf16*)(a.ws + WS_WIN); bf16* WoutT = (bf16*)(a.ws + WS_WOUT); bf16* W1T = (bf16*)(a.ws + WS_W1); bf16* W2T = (bf16*)(a.ws + WS_W2);
    for (int it = gw; it < NITEMS; it += NGW) {
        int r = it;
        if (r < I_IN) { const int kb = r / 128, nb = r % 128, dn0 = nb * 32; int sn0 = dn0; const int blk = dn0 / 512;
            if (blk == 5 || blk == 6) { const int tile = dn0 / 256, g = dn0 % 256, half = g / 128, head = (g % 128) / 32; sn0 = tile * 256 + head * 64 + half * 32; }
            transpose_item(a.in[10] + (size_t)layer * DM * INC, DM, INC, WinT, dn0, sn0, kb * 64, scr, lane); continue; } r -= I_IN;
        if (r < I_OUT) { const int kb = r / 32, nb = r % 32; transpose_item(a.in[18] + (size_t)layer * DM * DM, DM, DM, WoutT, nb * 32, nb * 32, kb * 64, scr, lane); continue; } r -= I_OUT;
        if (r < I_1) { const int kb = r / 176, nb = r % 176, dn0 = nb * 32; const int pn = dn0 / 256, bj = (dn0 % 256) / 128, x = dn0 % 128;
            transpose_item((bj ? a.in[20] : a.in[19]) + (size_t)layer * DM * FFH, DM, FFH, W1T, dn0, 128 * pn + x, kb * 64, scr, lane); continue; } r -= I_1;
        { const int kb = r / 32, nb = r % 32; transpose_item(a.in[21] + (size_t)layer * FFH * DM, FFH, DM, W2T, nb * 32, nb * 32, kb * 64, scr, lane); }
    }
}
__device__ __forceinline__ void mod_item(const Args& a, int item, LAS unsigned char* lds, int tid, int wave, int lane) {
    LAS float* sc = (LAS float*)lds; LAS float* red = (LAS float*)(lds + 81920);
    const int l = item / 96, n0 = (item % 96) * 64;
    for (int i = tid; i < NCB * DM; i += 512) { const int cb = i >> 10, k = i & 1023; const float v = cb < 4 ? a.in[2][cb * DM + k] : a.in[3][(cb - 4) * DM + k];
        sc[i] = v / (1.0f + __expf(-v)); }
    __syncthreads();
    float acc[NCB];
#pragma unroll
    for (int cb = 0; cb < NCB; ++cb) acc[cb] = 0.f;
    const float* wp = a.in[4] + (size_t)l * DM * 6144 + n0 + lane;
    for (int k = wave * 128; k < wave * 128 + 128; ++k) { const float wv = wp[(size_t)k * 6144];
#pragma unroll
        for (int cb = 0; cb < NCB; ++cb) acc[cb] += sc[cb * DM + k] * wv; }
#pragma unroll
    for (int cb = 0; cb < NCB; ++cb) red[(wave * NCB + cb) * 64 + lane] = acc[cb];
    __syncthreads();
    float* MOD = (float*)(a.ws + WS_MOD);
    for (int i = tid; i < NCB * 64; i += 512) { const int cb = i >> 6, ln = i & 63; float s = a.in[5][l * 6144 + n0 + ln];
#pragma unroll
        for (int w = 0; w < 8; ++w) s += red[(w * NCB + cb) * 64 + ln];
        MOD[(size_t)(l * NCB + cb) * 6144 + n0 + ln] = s; }
    __syncthreads();
}

#define XB_TMO      128
#define XB_XCNT(j)  (256  + 64 * (j))
#define XB_XSUB(j)  (1280 + 64 * (j))
#define XB_XGEN(j)  (2304 + 64 * (j))
#define XB_TOP      3328
#define XB_TOPGEN   3392
#define XCD_BAR_WORDS 3456
#define XB_SPIN_CAP (1u << 18)

__device__ __forceinline__ unsigned xb_ld(unsigned* p)              { return __hip_atomic_load(p, __ATOMIC_RELAXED, __HIP_MEMORY_SCOPE_AGENT); }
__device__ __forceinline__ unsigned xb_add(unsigned* p, unsigned v) { return __hip_atomic_fetch_add(p, v, __ATOMIC_RELAXED, __HIP_MEMORY_SCOPE_AGENT); }
__device__ __forceinline__ unsigned xb_xcc_id() { return (unsigned)__builtin_amdgcn_s_getreg((3 << 11) | 20) & 0xFu; }
#define XB_SPIN(cond, bar) do { unsigned _sp = 0; while (cond) { __builtin_amdgcn_s_sleep(1); \
    if ((++_sp & 255u) == 0u) { if (xb_ld(&(bar)[XB_TMO])) break; if (_sp > XB_SPIN_CAP) { atomicAdd(&(bar)[XB_TMO], 1u); break; } } } } while (0)

struct XcdBarrier {
    unsigned* bar; unsigned x;
    volatile LAS unsigned* st;
};

__device__ __forceinline__ XcdBarrier xcd_barrier_post(unsigned* bar, volatile LAS unsigned* st) {
    XcdBarrier b; b.bar = bar; b.x = xb_xcc_id(); b.st = st;
    if (threadIdx.x == 0) (void)xb_add(&bar[XB_XCNT(b.x)], 1u);
    return b;
}
__device__ __forceinline__ void xcd_barrier_complete(unsigned* bar, unsigned x, unsigned& nloc, unsigned& nx) {
    const unsigned G = gridDim.x * gridDim.y * gridDim.z;
    unsigned sum, cnt, mine, sp = 0u;
    for (;;) {
        sum = 0u; cnt = 0u; mine = 0u;
#pragma unroll
        for (unsigned j = 0; j < 16; ++j) { const unsigned c = xb_ld(&bar[XB_XCNT(j)]); sum += c; cnt += (c > 0u) ? 1u : 0u; mine = (j == x) ? c : mine; }
        if (sum == G) break;
        __builtin_amdgcn_s_sleep(1);
        if ((++sp & 255u) == 0u) { if (xb_ld(&bar[XB_TMO])) break; if (sp > XB_SPIN_CAP) { atomicAdd(&bar[XB_TMO], 1u); break; } }
    }
    nloc = mine > 0u ? mine : 1u; nx = cnt > 0u ? cnt : 1u;
}

__device__ __forceinline__ void xcd_barrier(const XcdBarrier& b) {
    asm volatile("s_waitcnt vmcnt(0)" ::: "memory");
    __syncthreads();
    if (threadIdx.x == 0) {
        unsigned* bar = b.bar;
        __builtin_amdgcn_s_waitcnt(0);
        unsigned nloc = b.st[0], nx = b.st[1];
        if (nloc == 0u) { xcd_barrier_complete(bar, b.x, nloc, nx); b.st[0] = nloc; b.st[1] = nx; }
        const unsigned old = xb_add(&bar[XB_XSUB(b.x)], 1u);
        const unsigned gen = old / nloc;
        if (old + 1u == (gen + 1u) * nloc) {
            __builtin_amdgcn_fence(__ATOMIC_RELEASE, "agent");
            asm volatile("s_waitcnt vmcnt(0)" ::: "memory");
            const unsigned og = xb_add(&bar[XB_TOP], 1u);
            const unsigned tg = og / nx;
            if (og + 1u == (tg + 1u) * nx) xb_add(&bar[XB_TOPGEN], 1u);
            else XB_SPIN(xb_ld(&bar[XB_TOPGEN]) == tg, bar);
            __builtin_amdgcn_fence(__ATOMIC_ACQUIRE, "agent");
            xb_add(&bar[XB_XGEN(b.x)], 1u);
            asm volatile("s_waitcnt vmcnt(0)" ::: "memory");
        } else {
            XB_SPIN(xb_ld(&bar[XB_XGEN(b.x)]) == gen, bar);
            __builtin_amdgcn_fence(__ATOMIC_ACQUIRE, "agent");
            asm volatile("s_waitcnt vmcnt(0)" ::: "memory");
        }
    }
    __syncthreads();
}

constexpr int LDS_BYTES = 147456;
constexpr int NPH = 18;
#ifndef REP_ATT
#define REP_ATT 1
#endif
#ifndef REP_GEMM
#define REP_GEMM 1
#endif
#ifndef REP_PRO
#define REP_PRO 1
#endif
#ifndef REP_ROW0
#define REP_ROW0 1
#endif
#ifndef EXTRA_SYNC
#define EXTRA_SYNC 0
#endif
#ifndef REP_HGC
#define REP_HGC 1
#endif
__global__ void __launch_bounds__(512, 2) mega_fwd(Args a) {
    extern __shared__ __attribute__((aligned(16))) unsigned char lds[];
    cg::grid_group grid = cg::this_grid();
    const int tid = threadIdx.x, lane = tid & 63, wave = __builtin_amdgcn_readfirstlane(tid >> 6);
    const int G = gridDim.x, bx = blockIdx.x;
    const int vcu = (G % 8 == 0) ? (bx % 8) * (G / 8) + bx / 8 : bx;
    const int gw = vcu * 8 + wave, NGW = G * 8;
    LAS unsigned char* lds3 = (LAS unsigned char*)lds;
    const int lo = a.ph_lo, hi = a.ph_hi;
    if (tid < 8) ((LAS unsigned*)(lds3 + LDS_BYTES - 32))[tid] = 0u;
    __syncthreads();
    XcdBarrier bar; bar.bar = (unsigned*)(a.ws + WS_BAR); bar.x = 0; bar.st = (volatile LAS unsigned*)(lds3 + LDS_BYTES - 32);
#define IN(k) (lo <= (k) && (k) < hi)
#define SEAM(k) do { if ((k) + 1 < hi) { if ((k) == 0) { grid.sync(); bar = xcd_barrier_post((unsigned*)(a.ws + WS_BAR), (volatile LAS unsigned*)(lds3 + LDS_BYTES - 32)); } else xcd_barrier(bar); } } while (0)
    bf16* BUFA = (bf16*)(a.ws + WS_BUFA); bf16* QKV = (bf16*)(a.ws + WS_QKV); bf16* YB = (bf16*)(a.ws + WS_Y);
    const float* cosT = (const float*)(a.ws + WS_COS); const float* sinT = (const float*)(a.ws + WS_SIN);

    if (IN(0)) {
      for (int rep = 0; rep < REP_PRO; ++rep) {
        int ln = lane, td = tid; asm volatile("" : "+v"(ln), "+v"(td));

#ifndef NO_MOD
        for (int item = bx; item < 192; item += G) mod_item(a, item, lds3, td, wave, ln);
#endif

        for (int gt = bx * 512 + td; gt < 4096 * 32; gt += G * 512) { { const int t = gt >> 5, i = gt & 31;
            const float inv = __builtin_amdgcn_exp2f(-(float)i * (13.287712379549449f / 32.0f));
            float rev = (float)t * inv * 0.15915494309189535f; rev = rev - floorf(rev);
            ((float*)(a.ws + WS_COS))[gt] = __builtin_amdgcn_cosf(rev); ((float*)(a.ws + WS_SIN))[gt] = __builtin_amdgcn_sinf(rev); } }
        if (bx == 0 && td < 16) ((unsigned*)(a.ws + WS_CTR))[64 * td] = 0u;
        if (bx == 0) for (int i = td; i < XCD_BAR_WORDS; i += 512) ((unsigned*)(a.ws + WS_BAR))[i] = 0u;
        convert_weights(a, 0, lds3, gw, NGW, wave, ln);
        __syncthreads();
      }
        for (int e = 0; e < EXTRA_SYNC; ++e) grid.sync();
        SEAM(0);
    }
    if (IN(1)) { for (int rep = 0; rep < REP_ROW0; ++rep) { int ln = lane; asm volatile("" : "+v"(ln)); rowpass(a, 0, 0, gw, NGW, ln); } SEAM(1); }
#pragma unroll 1
    for (int layer = 0; layer < 2; ++layer) {
        const int pb = 2 + 8 * layer;
        if (IN(pb + 0)) {
            pg8::Gemm g{BUFA, (const bf16*)(a.ws + WS_WIN), MTOK, INC, DM}; pg8::StaticOrder S; S.init(MTOK, INC, G, bx);
            pg8::EpiIn E{QKV, INC, cosT, sinT, 0.125f * 1.4426950408889634f};

#ifndef NO_GIN
            for (int rep = 0; rep < REP_GEMM; ++rep) pg8::gemm_phase<pg8::EpiIn, pg8::StaticOrder, true, true>(lds3, g, S, E);
#endif

            SEAM(pb + 0);
        }
        if (IN(pb + 1)) {
            int ln = lane; asm volatile("" : "+v"(ln));
            float s1 = a.in[13][layer * 64 + ln] * a.in[14][layer * 64 + ln], s2 = a.in[15][layer * 64 + ln] * a.in[16][layer * 64 + ln];
            s1 = wave_sum(s1); s2 = wave_sum(s2);
            const float linit = 0.8f - 0.6f * __expf(-0.3f * (float)layer);
            const float lam = __expf(s1) - __expf(s2) + linit, post = 1.0f - linit;
            const float* subln = a.in[17] + layer * 128;
            unsigned* ctr = (unsigned*)(a.ws + WS_CTR) + 64 * 8 * layer;
            volatile LAS unsigned* qslot = (volatile LAS unsigned*)(lds3 + LDS_BYTES - 64);
            int myq = (int)(xb_xcc_id() & 7u), adv = 0;
            constexpr int QLEN = 20 + 64 + 128;
            for (;;) {
                __syncthreads();
                if (tid == 0) { unsigned v = 0xffffffffu;
                    while (adv < 8) { v = __hip_atomic_fetch_add(ctr + 64 * myq, 1u, __ATOMIC_RELAXED, __HIP_MEMORY_SCOPE_AGENT); if (v < (unsigned)QLEN) break; v = 0xffffffffu; myq = (myq + 1) & 7; ++adv; }
                    *qslot = (v == 0xffffffffu) ? v : (((unsigned)myq << 16) | v); }
                __syncthreads();
                const unsigned qw = *qslot;
                if (qw == 0xffffffffu) break;
                const int qx = (int)(qw >> 16), li = (int)(qw & 0xffffu);
                int idx;
                if (li < 4) idx = qx * 4 + li;
                else if (li < 20) idx = 32 + qx * 16 + (li - 4);
                else if (li < 84) { const int j = li - 20; idx = 160 + (qx + 8 * (j >> 5)) * 32 + (j & 31); }
                else { const int j = li - 84; idx = 160 + 512 + (qx + 8 * (j >> 4)) * 16 + (j & 15); }
                if (idx < 160) {
#ifndef NO_HG
                    hg::chain(a, layer, idx, (char*)lds);
#endif
                } else {
                    const int u = idx - 160; int cb, hd, qb, T, row0;
                    if (u < 512) { cb = u >> 7; hd = (u >> 5) & 3; qb = u & 31; T = TP; row0 = cb * TP; }
                    else { const int u2 = u - 512; cb = 4 + (u2 >> 6); hd = (u2 >> 4) & 3; qb = u2 & 15; T = TS; row0 = NPROMPT + (cb - 4) * TS; }
                    const bf16* Qb = QKV + (size_t)(row0 + qb * 128) * INC + C_DQ + 128 * hd;
                    const bf16* Kh = QKV + (size_t)row0 * INC + C_DK + 128 * hd; const bf16* Vh = QKV + (size_t)row0 * INC + C_DV + 128 * hd;
                    bf16* Ob = BUFA + (size_t)(row0 + qb * 128) * DM + 512 + 128 * hd;
#ifndef NO_ATT
                    for (int rep = 0; rep < REP_ATT; ++rep) att::attn_unit(Qb, Kh, Vh, Ob, T, (char*)lds, lam, post, subln);
#endif
                }
            }
            SEAM(pb + 1);
        }
        if (IN(pb + 2)) { int ln = lane; asm volatile("" : "+v"(ln)); hg::combine_rows(a, layer, gw, NGW, ln); SEAM(pb + 2); }
        if (IN(pb + 3)) {
            pg8::Gemm g{BUFA, (const bf16*)(a.ws + WS_WOUT), MTOK, DM, DM}; pg8::StaticOrder S; S.init(MTOK, DM, G, bx);
            pg8::EpiPlain E{YB, DM};

#ifndef NO_GPL
            for (int rep = 0; rep < REP_GEMM; ++rep) pg8::gemm_phase<pg8::EpiPlain, pg8::StaticOrder, true, true>(lds3, g, S, E);
#endif

            SEAM(pb + 3);
        }
        if (IN(pb + 4)) { int ln = lane; asm volatile("" : "+v"(ln)); rowpass(a, layer, 1, gw, NGW, ln); SEAM(pb + 4); }
        if (IN(pb + 5)) {
            pg8::Gemm g{BUFA, (const bf16*)(a.ws + WS_W1), MTOK, 2 * FFH, DM}; pg8::StaticOrder S; S.init(MTOK, 2 * FFH, G, bx);
            pg8::EpiSwiGLU E{QKV, FFH};

#ifndef NO_GSW
            for (int rep = 0; rep < REP_GEMM; ++rep) pg8::gemm_phase<pg8::EpiSwiGLU, pg8::StaticOrder, true, true>(lds3, g, S, E);
#endif

            SEAM(pb + 5);
        }
        if (IN(pb + 6)) {
            pg8::Gemm g{QKV, (const bf16*)(a.ws + WS_W2), MTOK, DM, FFH}; pg8::StaticOrder S; S.init(MTOK, DM, G, bx, 1);
            pg8::EpiPlain E{YB, DM};

#ifndef NO_GPL
            for (int rep = 0; rep < REP_GEMM; ++rep) pg8::gemm_phase<pg8::EpiPlain, pg8::StaticOrder, true, true>(lds3, g, S, E);
#endif

            SEAM(pb + 6);
        }
        if (IN(pb + 7)) {
            int ln = lane; asm volatile("" : "+v"(ln));
            rowpass(a, layer, 2, gw, NGW, ln);
            if (layer == 0) convert_weights(a, 1, lds3, gw, NGW, wave, ln);
            SEAM(pb + 7);
        }
    }
#undef IN
#undef SEAM
}


#ifndef DBG_STOP
#define DBG_STOP 0
#endif
#ifndef DBG_DUMP
#define DBG_DUMP 0
#endif
__global__ void dbg_dump(Args a, int which) {
    const size_t n = (size_t)MTOK * DM;
    for (size_t i = (size_t)blockIdx.x * blockDim.x + threadIdx.x; i < n; i += (size_t)gridDim.x * blockDim.x) {
        const size_t m = i >> 10, c = i & 1023; float v = 0.f;
        if (which == 1) { const bf16* q = (const bf16*)(a.ws + WS_QKV) + m * INC + c; v = bf2f(q[0]) + bf2f(q[1024]) + bf2f(q[2048]) + bf2f(q[3072]); }
        else if (which == 2) v = bf2f(((const bf16*)(a.ws + WS_BUFA))[i]);
        else if (which == 3) v = bf2f(((const bf16*)(a.ws + WS_Y))[i]);
        a.out[i] = v;
    }
}
#ifndef MK_MULTI
#define MK_MULTI 0
#endif
extern "C" void kernel_launch(void* const* d_in, const int* in_sizes, int n_in, void* d_out, int out_size, void* d_ws, size_t ws_size, hipStream_t stream) {
    static int grid = 0;
    if (grid == 0) {
        if (n_in != 22 || out_size != MTOK * DM || ws_size < WS_END) { fprintf(stderr, "kernel_launch: unexpected shapes: n_in %d out %d ws %zu (need %zu)\n", n_in, out_size, ws_size, (size_t)WS_END); grid = -1; return; }
        int dev = 0, cus = 0, per_cu = 0;
        if (hipGetDevice(&dev) != hipSuccess || hipDeviceGetAttribute(&cus, hipDeviceAttributeMultiprocessorCount, dev) != hipSuccess) { grid = -1; return; }
        if (hipFuncSetAttribute((const void*)mega_fwd, hipFuncAttributeMaxDynamicSharedMemorySize, LDS_BYTES) != hipSuccess) { fprintf(stderr, "kernel_launch: hipFuncSetAttribute failed\n"); grid = -1; return; }
        if (hipOccupancyMaxActiveBlocksPerMultiprocessor(&per_cu, (const void*)mega_fwd, 512, LDS_BYTES) != hipSuccess || per_cu < 1) { fprintf(stderr, "kernel_launch: occupancy query says %d\n", per_cu); per_cu = 1; }
        (void)hipGetLastError();
        grid = cus;
    }
    if (grid < 0) return;
    Args a{};
    for (int i = 0; i < 22; ++i) a.in[i] = (const float*)d_in[i];
    a.out = (float*)d_out; a.ws = (unsigned char*)d_ws; a.xr = (ws_size >= WS_END + (size_t)MTOK * DM * 2) ? 1 : 0;
#if MK_MULTI
    for (int ph = 0; ph < (DBG_STOP ? DBG_STOP : NPH); ++ph) { a.ph_lo = ph; a.ph_hi = ph + 1; hipLaunchKernelGGL(mega_fwd, dim3(grid), dim3(512), LDS_BYTES, stream, a); }
    if (DBG_DUMP) hipLaunchKernelGGL(dbg_dump, dim3(2048), dim3(256), 0, stream, a, DBG_DUMP);
#else
    a.ph_lo = 0; a.ph_hi = NPH;
    void* args[] = {&a};
    hipError_t e = hipLaunchCooperativeKernel((const void*)mega_fwd, dim3(grid), dim3(512), args, LDS_BYTES, stream);
    if (e != hipSuccess) fprintf(stderr, "cooperative launch failed: %s (grid %d)\n", hipGetErrorString(e), grid);
#endif
}
```

```cpp
#include <hip/hip_runtime.h>
#include <hip/hip_bf16.h>
#include <hip/hip_cooperative_groups.h>
#include <cstdio>
#include <cstdint>
namespace cg = cooperative_groups;

namespace pg8 {
#define PG8_LAS __attribute__((address_space(3)))
typedef unsigned short bf16_t;
typedef short bf16x8 __attribute__((ext_vector_type(8)));
typedef float f32x4 __attribute__((ext_vector_type(4)));
typedef unsigned u32x4 __attribute__((ext_vector_type(4)));
constexpr int BM = 256, BK = 64, HALF = 128, HTB = HALF * BK * 2  , STAGE_BYTES = 8 * HTB, NXCD = 8, WGM = 8;

__host__ __device__ __forceinline__ int lds_byte(int r, int c) { const int st = (r >> 4) * 2 + (c >> 5), rr = r & 15, cc = c & 31, ob = rr * 64 + cc * 2; return st * 1024 + (ob ^ (((ob >> 9) & 1) << 5)); }
__host__ __device__ __forceinline__ void stage_rc(int b, int& R, int& C) { const int st = b / 1024, sb = b % 1024, swz = sb ^ (((sb >> 9) & 1) << 5); R = (st >> 1) * 16 + swz / 64; C = (st & 1) * 32 + (swz % 64) / 2; }
__host__ __device__ __forceinline__ int perm32(int rho) { const int n = rho >> 4, i = rho & 15; return 8 * (i >> 2) + 4 * n + (i & 3); }

struct Unit { int pm, pn; };
struct Gemm { const bf16_t* A; const bf16_t* Bt; int M, N, K; };

struct StaticOrder {
    int nM, nN, nwg, G, c, rev;
    __host__ __device__ void init(int M, int N, int G_, int c_, int rev_ = 0) { nM = M / BM; nN = N / BM; nwg = nM * nN; G = G_; c = c_; rev = rev_; }
    __host__ __device__ bool next(int i, Unit& u) const {
        const long L = (long)i * G + c; if (L >= nwg) return false;
        int wgid = (int)L; { const int q = nwg / NXCD, r = nwg % NXCD, xcd = wgid % NXCD, off = wgid / NXCD; wgid = (xcd < r ? xcd * (q + 1) : r * (q + 1) + (xcd - r) * q) + off; }
        const int nig = WGM * nN, gid = wgid / nig, fm = gid * WGM, gsz = (nM - fm) < WGM ? (nM - fm) : WGM;
        u.pm = fm + ((wgid % nig) % gsz); u.pn = (wgid % nig) / gsz; if (rev) u.pm = nM - 1 - u.pm; return true;
    }
    __device__ __forceinline__ void a_ready(const Unit&) const {}
    __device__ __forceinline__ void done(const Unit&) const {}
};

typedef float f32x2_t __attribute__((ext_vector_type(2))); typedef __bf16 bf16x2_t __attribute__((ext_vector_type(2)));
__device__ __forceinline__ unsigned cvt_pk_bf16(float lo, float hi) { f32x2_t v = {lo, hi}; bf16x2_t b = __builtin_convertvector(v, bf16x2_t); return __builtin_bit_cast(unsigned, b); }
__device__ __forceinline__ float fast_rcp(float x) { return __builtin_amdgcn_rcpf(x); }
__device__ __forceinline__ float silu_f(float x) { return x * fast_rcp(1.0f + __builtin_amdgcn_exp2f(-1.4426950408889634f * x)); }
__device__ __forceinline__ float signeg_f(float x) { return fast_rcp(1.0f + __builtin_amdgcn_exp2f(1.4426950408889634f * x)); }
__device__ __forceinline__ u32x4 pack8(const f32x4& a, const f32x4& b) { u32x4 w; w.x = cvt_pk_bf16(a[0], a[1]); w.y = cvt_pk_bf16(a[2], a[3]); w.z = cvt_pk_bf16(b[0], b[1]); w.w = cvt_pk_bf16(b[2], b[3]); return w; }

struct EpiPlain {
    static constexpr bool PERM = true, AFTER_DRAIN = false;
    bf16_t* O; int ldc;
    __device__ __forceinline__ void operator()(const f32x4 (&acc)[2][2][4][2], const Unit& u, int wr, int wc, int fr, int fq) const {
        const int row0 = u.pm * BM + wr * 64 + fr, col0 = u.pn * BM + wc * 32 + 8 * fq;
#pragma unroll
        for (int ai = 0; ai < 2; ++ai)
#pragma unroll
            for (int m = 0; m < 4; ++m) { bf16_t* rowp = O + (size_t)(row0 + ai * HALF + m * 16) * ldc + col0;
#pragma unroll
                for (int bj = 0; bj < 2; ++bj) *(u32x4*)(rowp + bj * HALF) = pack8(acc[ai][bj][m][0], acc[ai][bj][m][1]); }
    }
};
struct EpiSwiGLU {
    static constexpr bool PERM = true, AFTER_DRAIN = false;
    bf16_t* O; int ldc;
    __device__ __forceinline__ void operator()(const f32x4 (&acc)[2][2][4][2], const Unit& u, int wr, int wc, int fr, int fq) const {
        const int row0 = u.pm * BM + wr * 64 + fr, col0 = u.pn * HALF + wc * 32 + 8 * fq;
#pragma unroll
        for (int ai = 0; ai < 2; ++ai)
#pragma unroll
            for (int m = 0; m < 4; ++m) { bf16_t* rowp = O + (size_t)(row0 + ai * HALF + m * 16) * ldc + col0;
                f32x4 h0, h1;
#pragma unroll
                for (int e = 0; e < 4; ++e) { h0[e] = silu_f(acc[ai][0][m][0][e]) * acc[ai][1][m][0][e]; h1[e] = silu_f(acc[ai][0][m][1][e]) * acc[ai][1][m][1][e]; }
                *(u32x4*)rowp = pack8(h0, h1); }
    }
};
struct EpiIn {
    static constexpr bool PERM = true, AFTER_DRAIN = false;
    bf16_t* O; int ldc; const float* cosT; const float* sinT; float qscale;
    __device__ __forceinline__ void operator()(const f32x4 (&acc)[2][2][4][2], const Unit& u, int wr, int wc, int fr, int fq) const {
        const int row0 = u.pm * BM + wr * 64 + fr; const int blk = u.pn >> 1;
        if (blk == 5 || blk == 6) {
            const float sc = (blk == 5) ? qscale : 1.0f; const int colh = u.pn * BM + 64 * wc + 8 * fq;
#pragma unroll
            for (int ai = 0; ai < 2; ++ai)
#pragma unroll
                for (int m = 0; m < 4; ++m) { const int row = row0 + ai * HALF + m * 16; const int t = row < 16384 ? (row & 4095) : (row & 2047);
                    bf16_t* rowp = O + (size_t)row * ldc + colh; f32x4 o1[2], o2[2];
#pragma unroll
                    for (int n = 0; n < 2; ++n) { const f32x4 c4 = *(const f32x4*)(cosT + t * 32 + 8 * fq + 4 * n), s4 = *(const f32x4*)(sinT + t * 32 + 8 * fq + 4 * n);
                        const f32x4 x1 = acc[ai][0][m][n], x2 = acc[ai][1][m][n];
                        o1[n] = (x1 * c4 - x2 * s4) * sc; o2[n] = (x2 * c4 + x1 * s4) * sc; }
                    *(u32x4*)rowp = pack8(o1[0], o1[1]); *(u32x4*)(rowp + 32) = pack8(o2[0], o2[1]); }
        } else {
            const int act = (blk == 0) ? 1 : ((blk == 1 || blk == 2) ? 2 : 0);     const int col0 = u.pn * BM + wc * 32 + 8 * fq;
#pragma unroll
            for (int ai = 0; ai < 2; ++ai)
#pragma unroll
                for (int m = 0; m < 4; ++m) { bf16_t* rowp = O + (size_t)(row0 + ai * HALF + m * 16) * ldc + col0;
#pragma unroll
                    for (int bj = 0; bj < 2; ++bj) { f32x4 v0 = acc[ai][bj][m][0], v1 = acc[ai][bj][m][1];
                        if (act == 1) {
#pragma unroll
                            for (int e = 0; e < 4; ++e) { v0[e] = silu_f(v0[e]); v1[e] = silu_f(v1[e]); } }
                        else if (act == 2) {
#pragma unroll
                            for (int e = 0; e < 4; ++e) { v0[e] = signeg_f(v0[e]); v1[e] = signeg_f(v1[e]); } }
                        *(u32x4*)(rowp + bj * HALF) = pack8(v0, v1); } }
        }
    }
};

template <class Epi, class Sched, bool ALIGN_EPI = false, bool SP2 = false>
__device__ __forceinline__ void gemm_phase(PG8_LAS unsigned char* lds, const Gemm g, const Sched& S, const Epi& E) {
    int tid_l = threadIdx.x; asm volatile("" : "+v"(tid_l));
    const int tid = tid_l, wid = __builtin_amdgcn_readfirstlane(tid >> 6), lane = tid & 63, wr = wid >> 2, wc = wid & 3, fr = lane & 15, fq = lane >> 4;
    const int K = g.K, nt = K / BK;
    unsigned voffA[2], voffB[2];
#pragma unroll
    for (int i = 0; i < 2; ++i) { int R, C; stage_rc(tid * 16 + i * 8192, R, C); const int Rb = Epi::PERM ? ((R & ~31) + perm32(R & 31)) : R;
        voffA[i] = (unsigned)(R * K + C) * 2u; voffB[i] = (unsigned)(Rb * K + C) * 2u; }
    const size_t kstep = (size_t)(BK * 2);
    const size_t hstep = (size_t)HALF * K * 2;
    const size_t tstep = 2 * hstep;
    const unsigned ldsw = (unsigned)wid * 1024u;
    const int aoff = lds_byte(wr * 64 + fr, fq * 8), boff = lds_byte(wc * 32 + fr, fq * 8);
#define PG8_SA(b, h) (((b) * 2 + (h)) * HTB)
#define PG8_SB(b, h) ((4 + (b) * 2 + (h)) * HTB)
#define PG8_STAGE(bufoff, gbase, voff) do { _Pragma("unroll") for (int _i = 0; _i < 2; ++_i) \
        __builtin_amdgcn_global_load_lds((const unsigned*)((const char*)(gbase) + (voff)[_i]), (PG8_LAS unsigned*)(lds + (bufoff) + ldsw + _i * 8192), 16, 0, 0); } while (0)
#define PG8_LDA(dst, b, h) do { _Pragma("unroll") for (int m = 0; m < 4; ++m) _Pragma("unroll") for (int k = 0; k < 2; ++k) dst[m][k] = *(const PG8_LAS bf16x8*)(lds + PG8_SA(b, h) + aoff + m * 2048 + k * 1024); } while (0)
#define PG8_LDB(dst, b, h) do { _Pragma("unroll") for (int n = 0; n < 2; ++n) _Pragma("unroll") for (int k = 0; k < 2; ++k) dst[n][k] = *(const PG8_LAS bf16x8*)(lds + PG8_SB(b, h) + boff + n * 2048 + k * 1024); } while (0)
#define PG8_MMA(ai, bj, At, Bt) do { __builtin_amdgcn_s_setprio(1); _Pragma("unroll") for (int m = 0; m < 4; ++m) _Pragma("unroll") for (int n = 0; n < 2; ++n) _Pragma("unroll") for (int k = 0; k < 2; ++k) \
        acc[ai][bj][m][n] = __builtin_amdgcn_mfma_f32_16x16x32_bf16(Bt[n][k], At[m][k], acc[ai][bj][m][n], 0, 0, 0); __builtin_amdgcn_s_setprio(0); } while (0)
#define PG8_WAIT_V(n) asm volatile("s_waitcnt vmcnt(" #n ")" ::: "memory")
#define PG8_WAIT_L(n) asm volatile("s_waitcnt lgkmcnt(" #n ")" ::: "memory")
#define PG8_BAR __builtin_amdgcn_s_barrier()
#define PG8_SCHED __builtin_amdgcn_sched_barrier(0)
    Unit cur, nxt; int ui = 0;
    if (!S.next(0, cur)) return;
    f32x4 acc[2][2][4][2];
#pragma unroll
    for (int a = 0; a < 2; ++a)
#pragma unroll
        for (int b = 0; b < 2; ++b)
#pragma unroll
            for (int m = 0; m < 4; ++m)
#pragma unroll
                for (int n = 0; n < 2; ++n) acc[a][b][m][n] = (f32x4){0.f, 0.f, 0.f, 0.f};
    bf16x8 At[4][2], B0[2][2], B1[2][2];
    const char* cA = (const char*)g.A + (size_t)cur.pm * tstep; const char* cB = (const char*)g.Bt + (size_t)cur.pn * tstep;
    S.a_ready(cur);
    if constexpr (SP2) {
        PG8_STAGE(PG8_SB(0, 0), cB, voffB); PG8_STAGE(PG8_SB(0, 1), cB + hstep, voffB); PG8_STAGE(PG8_SA(0, 0), cA, voffA); PG8_STAGE(PG8_SA(0, 1), cA + hstep, voffA);
        if (wr == 1) PG8_BAR;
        PG8_WAIT_V(2); PG8_BAR;
        PG8_STAGE(PG8_SB(1, 0), cB + kstep, voffB); PG8_STAGE(PG8_SA(1, 0), cA + kstep, voffA); PG8_STAGE(PG8_SB(1, 1), cB + hstep + kstep, voffB);
        PG8_WAIT_V(6); PG8_BAR;
    } else {
        PG8_STAGE(PG8_SB(0, 0), cB, voffB); PG8_STAGE(PG8_SA(0, 0), cA, voffA); PG8_STAGE(PG8_SB(0, 1), cB + hstep, voffB); PG8_STAGE(PG8_SA(0, 1), cA + hstep, voffA);
        if (wr == 1) PG8_BAR;
        PG8_WAIT_V(4); PG8_BAR;
        PG8_STAGE(PG8_SB(1, 0), cB + kstep, voffB); PG8_STAGE(PG8_SA(1, 0), cA + kstep, voffA); PG8_STAGE(PG8_SB(1, 1), cB + hstep + kstep, voffB);
        PG8_WAIT_V(6); PG8_BAR;
    }
    for (;;) {
        const bool has_next = S.next(ui + 1, nxt);
        const char* nA = has_next ? (const char*)g.A + (size_t)nxt.pm * tstep : cA; const char* nB = has_next ? (const char*)g.Bt + (size_t)nxt.pn * tstep : cB;
        for (int t = 0; t < nt; t += 2) {
            const bool last = (t == nt - 2);
            const char* a1 = cA + (size_t)(t + 1) * kstep;
            const char* a2 = last ? nA : cA + (size_t)(t + 2) * kstep; const char* b2 = last ? nB : cB + (size_t)(t + 2) * kstep;
            const char* a3 = a2 + kstep; const char* b3 = b2 + kstep;
            if (last && has_next) S.a_ready(nxt);
            if constexpr (SP2) {
            PG8_LDB(B0, 0, 0); PG8_LDB(B1, 0, 1); PG8_SCHED; PG8_LDA(At, 0, 0); PG8_STAGE(PG8_SA(1, 1), a1 + hstep, voffA);
            PG8_WAIT_V(8); PG8_WAIT_L(0); PG8_BAR; PG8_MMA(0, 0, At, B0); PG8_MMA(0, 1, At, B1); PG8_BAR; PG8_SCHED;
            PG8_LDA(At, 0, 1); PG8_STAGE(PG8_SB(0, 0), b2, voffB); PG8_STAGE(PG8_SB(0, 1), b2 + hstep, voffB); PG8_STAGE(PG8_SA(0, 0), a2, voffA);
            PG8_WAIT_V(8); PG8_WAIT_L(0); PG8_BAR; PG8_MMA(1, 0, At, B0); PG8_MMA(1, 1, At, B1); PG8_BAR; PG8_SCHED;
            PG8_LDB(B0, 1, 0); PG8_LDB(B1, 1, 1); PG8_SCHED; PG8_LDA(At, 1, 0); PG8_STAGE(PG8_SA(0, 1), a2 + hstep, voffA);
            PG8_WAIT_V(8); PG8_WAIT_L(0); PG8_BAR; PG8_MMA(0, 0, At, B0); PG8_MMA(0, 1, At, B1); PG8_BAR; PG8_SCHED;
            PG8_LDA(At, 1, 1); PG8_STAGE(PG8_SB(1, 0), b3, voffB); PG8_STAGE(PG8_SB(1, 1), b3 + hstep, voffB); PG8_STAGE(PG8_SA(1, 0), a3, voffA);
            PG8_WAIT_V(8); PG8_WAIT_L(0); PG8_BAR; PG8_MMA(1, 0, At, B0); PG8_MMA(1, 1, At, B1); PG8_BAR; PG8_SCHED;
            } else {
            PG8_LDB(B0, 0, 0); PG8_SCHED; PG8_LDA(At, 0, 0); PG8_STAGE(PG8_SA(1, 1), a1 + hstep, voffA);
            PG8_WAIT_L(8); PG8_BAR; PG8_WAIT_L(0); PG8_MMA(0, 0, At, B0); PG8_BAR; PG8_SCHED;
            PG8_LDB(B1, 0, 1); PG8_STAGE(PG8_SB(0, 0), b2, voffB);
            PG8_BAR; PG8_WAIT_L(0); PG8_MMA(0, 1, At, B1); PG8_BAR;
            PG8_LDA(At, 0, 1); PG8_STAGE(PG8_SA(0, 0), a2, voffA);
            PG8_BAR; PG8_WAIT_L(0); PG8_MMA(1, 0, At, B0); PG8_BAR; PG8_SCHED;
            PG8_STAGE(PG8_SB(0, 1), b2 + hstep, voffB);
            PG8_WAIT_V(6); PG8_BAR; PG8_MMA(1, 1, At, B1); PG8_BAR;
            PG8_LDB(B0, 1, 0); PG8_SCHED; PG8_LDA(At, 1, 0); PG8_STAGE(PG8_SA(0, 1), a2 + hstep, voffA);
            PG8_WAIT_L(8); PG8_BAR; PG8_WAIT_L(0); PG8_MMA(0, 0, At, B0); PG8_BAR; PG8_SCHED;
            PG8_LDB(B1, 1, 1); PG8_STAGE(PG8_SB(1, 0), b3, voffB);
            PG8_BAR; PG8_WAIT_L(0); PG8_MMA(0, 1, At, B1); PG8_BAR;
            PG8_LDA(At, 1, 1); PG8_STAGE(PG8_SA(1, 0), a3, voffA);
            PG8_BAR; PG8_WAIT_L(0); PG8_MMA(1, 0, At, B0); PG8_BAR; PG8_SCHED;
            PG8_STAGE(PG8_SB(1, 1), b3 + hstep, voffB);
            PG8_WAIT_V(6); PG8_BAR; PG8_MMA(1, 1, At, B1); PG8_BAR;
            }
        }
        if constexpr (ALIGN_EPI) { if (wr == 0) PG8_BAR; }
        if constexpr (!Epi::AFTER_DRAIN) { E(acc, cur, wr, wc, fr, fq); S.done(cur); }
        if (!has_next) break;
#pragma unroll
        for (int a = 0; a < 2; ++a)
#pragma unroll
            for (int b = 0; b < 2; ++b)
#pragma unroll
                for (int m = 0; m < 4; ++m)
#pragma unroll
                    for (int n = 0; n < 2; ++n) acc[a][b][m][n] = (f32x4){0.f, 0.f, 0.f, 0.f};
        cur = nxt; cA = nA; cB = nB; ++ui;
        if constexpr (ALIGN_EPI) { if (wr == 1) PG8_BAR; }
    }
    PG8_WAIT_V(0);
    if constexpr (!ALIGN_EPI) { if (wr == 0) PG8_BAR; }
    PG8_BAR;
    if constexpr (Epi::AFTER_DRAIN) { E.fused(acc, cur, wr, wc, fr, fq, lds, wid, lane); S.done(cur); }
#undef PG8_SA
#undef PG8_SB
#undef PG8_STAGE
#undef PG8_LDA
#undef PG8_LDB
#undef PG8_MMA
#undef PG8_WAIT_V
#undef PG8_WAIT_L
#undef PG8_BAR
#undef PG8_SCHED
}
}
namespace att {
using bf16x8 = __attribute__((ext_vector_type(8))) short;
using s16x4  = __attribute__((ext_vector_type(4))) short;
using f32x16 = __attribute__((ext_vector_type(16))) float;
using u32x4  = __attribute__((ext_vector_type(4))) unsigned;
constexpr int NW = 8, QBLK = 32, KVBLK = 64, LD = 4096;
constexpr float THRL = 11.5f;
constexpr int SHM_V = KVBLK * 128 * 2, SHM_K = KVBLK * 128 * 2, SHM_ATTN = 2 * SHM_V + 2 * SHM_K + NW * 64 * 4;
#define KSWZ(row, colB) ((row) * 256 + ((colB) ^ (((row) & 7) << 4)))
#define SBAR() __builtin_amdgcn_sched_barrier(0)
__device__ __forceinline__ int crow(int r, int hi) { return (r & 3) + 8 * (r >> 2) + 4 * hi; }
__device__ __forceinline__ unsigned cvtpk(float lo, float hi) { return pg8::cvt_pk_bf16(lo, hi); }

__device__ __forceinline__ void partialSM(f32x16& p0, f32x16& p1, float& m_reg, float& mn, float& alpha) {
  float pmax = p0[0];
#pragma unroll
  for (int r = 1; r < 16; ++r) pmax = fmaxf(pmax, p0[r]);
#pragma unroll
  for (int r = 0; r < 16; ++r) pmax = fmaxf(pmax, p1[r]);
  { auto rr = __builtin_amdgcn_permlane32_swap(__float_as_uint(pmax), __float_as_uint(pmax), false, false);
    pmax = fmaxf(__uint_as_float(rr[0]), __uint_as_float(rr[1])); }
  if (__builtin_expect(__all(pmax - m_reg <= THRL), 1)) { mn = m_reg; alpha = 1.f; }
  else { mn = fmaxf(m_reg, pmax); alpha = __builtin_amdgcn_exp2f(m_reg - mn); m_reg = mn; }
#pragma unroll
  for (int r = 0; r < 16; ++r) p0[r] = p0[r] - mn;
#pragma unroll
  for (int r = 0; r < 16; ++r) p1[r] = p1[r] - mn;
#pragma unroll
  for (int r = 0; r < 16; ++r) p0[r] = __builtin_amdgcn_exp2f(p0[r]);
}
__device__ __forceinline__ void finishSM(f32x16& p0, f32x16& p1, float alpha, float& l_reg, bf16x8& pa0, bf16x8& pa1, bf16x8& pa2, bf16x8& pa3) {
#pragma unroll
  for (int r = 0; r < 16; ++r) p1[r] = __builtin_amdgcn_exp2f(p1[r]);
  float ps = 0;
#pragma unroll
  for (int r = 0; r < 16; ++r) ps += p0[r];
#pragma unroll
  for (int r = 0; r < 16; ++r) ps += p1[r];
  { auto rr = __builtin_amdgcn_permlane32_swap(__float_as_uint(ps), __float_as_uint(ps), false, false);
    ps = __uint_as_float(rr[0]) + __uint_as_float(rr[1]); }
  l_reg = l_reg * alpha + ps;
#define PK4(P, BASE, OUT) do { unsigned a0 = cvtpk(P[BASE + 0], P[BASE + 1]), a1 = cvtpk(P[BASE + 2], P[BASE + 3]);   \
    unsigned b0 = cvtpk(P[BASE + 4], P[BASE + 5]), b1 = cvtpk(P[BASE + 6], P[BASE + 7]);                              \
    auto r0 = __builtin_amdgcn_permlane32_swap(a0, b0, false, false); auto r1 = __builtin_amdgcn_permlane32_swap(a1, b1, false, false); \
    u32x4 w = {r0[0], r1[0], r0[1], r1[1]}; OUT = *reinterpret_cast<bf16x8*>(&w); } while (0)
  PK4(p0, 0, pa0); PK4(p0, 8, pa1); PK4(p1, 0, pa2); PK4(p1, 8, pa3);
#undef PK4
}
__device__ __forceinline__ void qkt(f32x16& p0, f32x16& p1, const char* Ks, const bf16x8* qr, int r32, int hi, int sub) {
  p0 = f32x16{}; p1 = f32x16{};
#pragma unroll
  for (int d0 = 0; d0 < 4; ++d0) { int cb = ((sub * 4 + d0) * 16 + hi * 8) * 2;
    bf16x8 b0 = *reinterpret_cast<const bf16x8*>(Ks + KSWZ(r32, cb));
    bf16x8 b1 = *reinterpret_cast<const bf16x8*>(Ks + KSWZ(32 + r32, cb));
    p0 = __builtin_amdgcn_mfma_f32_32x32x16_bf16(b0, qr[d0], p0, 0, 0, 0);
    p1 = __builtin_amdgcn_mfma_f32_32x32x16_bf16(b1, qr[d0], p1, 0, 0, 0); }
}
__device__ __forceinline__ int v_st(int k, int c) { const int kk = (k & ~0xC) | ((k & 4) << 1) | ((k & 8) >> 1); return ((kk >> 3) * 4 + (c >> 5)) * 512 + ((kk & 7) * 32 + (c & 31)) * 2; }
__device__ __forceinline__ int v_rd_base(int lane) { return ((lane & 3) << 3) | (((lane >> 2) & 3) << 6) | (((lane >> 4) & 1) << 5) | (((lane >> 5) & 1) << 8); }
constexpr int v_rd_off(int d0, int ks, int half) { return d0 * 512 + ks * 4096 + half * 2048; }
template <int OFF> __device__ __forceinline__ s16x4 tr_read(int vb) {
  s16x4 r; asm volatile("ds_read_b64_tr_b16 %0, %1 offset:%2" : "=&v"(r) : "v"(vb), "i"(OFF) : "memory"); return r;
}
template <int D0> __device__ __forceinline__ void pv_one(f32x16& od, int vb, bf16x8 pa0, bf16x8 pa1, bf16x8 pa2, bf16x8 pa3) {
  const s16x4 l0 = tr_read<v_rd_off(D0, 0, 0)>(vb), h0 = tr_read<v_rd_off(D0, 0, 1)>(vb), l1 = tr_read<v_rd_off(D0, 1, 0)>(vb), h1 = tr_read<v_rd_off(D0, 1, 1)>(vb);
  const s16x4 l2 = tr_read<v_rd_off(D0, 2, 0)>(vb), h2 = tr_read<v_rd_off(D0, 2, 1)>(vb), l3 = tr_read<v_rd_off(D0, 3, 0)>(vb), h3 = tr_read<v_rd_off(D0, 3, 1)>(vb);
  asm volatile("s_waitcnt lgkmcnt(0)" ::: "memory"); SBAR();
#define PK(L, H) (bf16x8){L[0], L[1], L[2], L[3], H[0], H[1], H[2], H[3]}
  od = __builtin_amdgcn_mfma_f32_32x32x16_bf16(pa0, PK(l0, h0), od, 0, 0, 0);
  od = __builtin_amdgcn_mfma_f32_32x32x16_bf16(pa1, PK(l1, h1), od, 0, 0, 0);
  od = __builtin_amdgcn_mfma_f32_32x32x16_bf16(pa2, PK(l2, h2), od, 0, 0, 0);
  od = __builtin_amdgcn_mfma_f32_32x32x16_bf16(pa3, PK(l3, h3), od, 0, 0, 0);
#undef PK
}
__device__ __forceinline__ void pv_d0(f32x16* o, int vb, bf16x8 pa0, bf16x8 pa1, bf16x8 pa2, bf16x8 pa3) {
  pv_one<0>(o[0], vb, pa0, pa1, pa2, pa3); pv_one<1>(o[1], vb, pa0, pa1, pa2, pa3); pv_one<2>(o[2], vb, pa0, pa1, pa2, pa3); pv_one<3>(o[3], vb, pa0, pa1, pa2, pa3);
}

__device__ __forceinline__ void attn_unit(const unsigned short* __restrict__ Qb, const unsigned short* __restrict__ Kh, const unsigned short* __restrict__ Vh,
                                          unsigned short* __restrict__ Ob, int seq, char* lds, float lam, float post, const float* __restrict__ subln) {
  int tid_l = threadIdx.x; asm volatile("" : "+v"(tid_l));
  const int tid = tid_l, wid = tid >> 6, lane = tid & 63, r32 = lane & 31, hi = lane >> 5;
  const int sub = __builtin_amdgcn_readfirstlane(wid >> 2), wq = __builtin_amdgcn_readfirstlane(wid & 3);
  char* V_lds = lds; char* K_lds = lds + 2 * SHM_V;
  float* ws = (float*)(lds + 2 * SHM_V + 2 * SHM_K) + wid * 64; float* li_l = ws; float* al_l = ws + 32;
  float m_reg = -1e30f, l_reg = 0; f32x16 o[4] = {}; bf16x8 qr[4];
  const unsigned short* Qw = Qb + (long)(wq * QBLK + r32) * LD + sub * 64 + hi * 8;
#pragma unroll
  for (int d0 = 0; d0 < 4; ++d0) qr[d0] = *reinterpret_cast<const bf16x8*>(Qw + d0 * 16);
  const int sr = tid >> 4, sc = (tid & 15) * 8, vst0 = v_st(sr, sc), vst1 = v_st(32 + sr, sc);
  const int vb0 = (int)(uintptr_t)V_lds + v_rd_base(lane);
  struct { bf16x8 vs0, vs1, ks0, ks1; } sr_[2];
#define SLOAD(i, k0) do { sr_[i].vs0 = *reinterpret_cast<const bf16x8*>(&Vh[(long)((k0) + sr) * LD + sc]); sr_[i].vs1 = *reinterpret_cast<const bf16x8*>(&Vh[(long)((k0) + 32 + sr) * LD + sc]); \
    sr_[i].ks0 = *reinterpret_cast<const bf16x8*>(&Kh[(long)((k0) + sr) * LD + sc]); sr_[i].ks1 = *reinterpret_cast<const bf16x8*>(&Kh[(long)((k0) + 32 + sr) * LD + sc]); } while (0)
#define SWRITE(b, i) do { *(bf16x8*)(V_lds + (b) * SHM_V + vst0) = sr_[i].vs0;          \
    *(bf16x8*)(V_lds + (b) * SHM_V + vst1) = sr_[i].vs1; int kc = sc * 2;               \
    *(bf16x8*)(K_lds + (b) * SHM_K + KSWZ(sr, kc)) = sr_[i].ks0;                       \
    *(bf16x8*)(K_lds + (b) * SHM_K + KSWZ(32 + sr, kc)) = sr_[i].ks1; } while (0)
#define SWAIT() asm volatile("s_waitcnt vmcnt(4)" ::: "memory")
#define RESC(a) do { if (__any((a) < 1.f)) { if (hi == 0) al_l[r32] = (a); asm volatile("s_waitcnt lgkmcnt(0)" ::: "memory"); \
    _Pragma("unroll") for (int d = 0; d < 4; ++d) _Pragma("unroll") for (int r = 0; r < 16; ++r) o[d][r] *= al_l[crow(r, hi)]; } } while (0)
  f32x16 pA0, pA1, pB0, pB1; float mnA, mnB, alA, alB; bf16x8 pa0, pa1, pa2, pa3; const int NT = seq / KVBLK;
  constexpr int SE = 0, SO = 1;
  SLOAD(SE, 0); asm volatile("s_waitcnt vmcnt(0)" ::: "memory"); SWRITE(0, SE); __syncthreads();
  qkt(pA0, pA1, K_lds, qr, r32, hi, sub); partialSM(pA0, pA1, m_reg, mnA, alA);
  SLOAD(SO, KVBLK); if (2 < NT) SLOAD(SE, 2 * KVBLK);
  SWAIT(); SWRITE(1, SO); __syncthreads();
  for (int j = 1; j + 1 < NT; j += 2) {
    SBAR(); qkt(pB0, pB1, K_lds + SHM_K, qr, r32, hi, sub);
    finishSM(pA0, pA1, alA, l_reg, pa0, pa1, pa2, pa3); SBAR();
    SLOAD(SO, (j + 2) * KVBLK); SBAR();
    pv_d0(o, vb0, pa0, pa1, pa2, pa3); partialSM(pB0, pB1, m_reg, mnB, alB);
    __syncthreads(); SWAIT(); SWRITE(0, SE);
    RESC(alB); __syncthreads();
    SBAR(); qkt(pA0, pA1, K_lds, qr, r32, hi, sub);
    finishSM(pB0, pB1, alB, l_reg, pa0, pa1, pa2, pa3); SBAR();
    if (j + 3 < NT) SLOAD(SE, (j + 3) * KVBLK); SBAR();
    pv_d0(o, vb0 + (int)SHM_V, pa0, pa1, pa2, pa3); partialSM(pA0, pA1, m_reg, mnA, alA);
    __syncthreads(); SWAIT(); SWRITE(1, SO);
    RESC(alA); __syncthreads();
  }
  SBAR(); qkt(pB0, pB1, K_lds + SHM_K, qr, r32, hi, sub);
  finishSM(pA0, pA1, alA, l_reg, pa0, pa1, pa2, pa3); SBAR();
  pv_d0(o, vb0, pa0, pa1, pa2, pa3); partialSM(pB0, pB1, m_reg, mnB, alB);
  __syncthreads(); RESC(alB);
  finishSM(pB0, pB1, alB, l_reg, pa0, pa1, pa2, pa3); SBAR();
  pv_d0(o, vb0 + (int)SHM_V, pa0, pa1, pa2, pa3);
  if (hi == 0) li_l[r32] = l_reg; asm volatile("s_waitcnt lgkmcnt(0)" ::: "memory");
  float rli[16];
#pragma unroll
  for (int r = 0; r < 16; ++r) rli[r] = __builtin_amdgcn_rcpf(li_l[crow(r, hi)]);
  asm volatile("s_waitcnt vmcnt(0)" ::: "memory");
  __syncthreads();
  float* X = (float*)lds;
  if (sub == 1) {
#pragma unroll
    for (int r = 0; r < 16; ++r) { const int orow = crow(r, hi);
#pragma unroll
      for (int d0 = 0; d0 < 4; ++d0) X[(wq * 32 + orow) * 128 + d0 * 32 + r32] = o[d0][r] * rli[r]; }
  }
  __syncthreads();
  if (sub == 0) {
    float sw[4];
#pragma unroll
    for (int d0 = 0; d0 < 4; ++d0) sw[d0] = subln[d0 * 32 + r32] * post;
    unsigned short* Ow = Ob + (long)(wq * QBLK) * 1024;
#pragma unroll
    for (int r = 0; r < 16; ++r) { const int orow = crow(r, hi); float ss = 0.f; float v[4];
#pragma unroll
      for (int d0 = 0; d0 < 4; ++d0) { v[d0] = o[d0][r] * rli[r] - lam * X[(wq * 32 + orow) * 128 + d0 * 32 + r32]; ss += v[d0] * v[d0]; }
      ss += __shfl_xor(ss, 1); ss += __shfl_xor(ss, 2); ss += __shfl_xor(ss, 4); ss += __shfl_xor(ss, 8); ss += __shfl_xor(ss, 16);
      const float rs = __builtin_amdgcn_rsqf(ss * (1.0f / 128.0f) + 1e-5f);
#pragma unroll
      for (int d0 = 0; d0 < 4; ++d0) { const float ov = v[d0] * rs * sw[d0]; Ow[(long)orow * 1024 + d0 * 32 + r32] = (unsigned short)(cvtpk(ov, ov) & 0xffffu); } }
  }
  __syncthreads();
#undef SLOAD
#undef SWRITE
#undef SWAIT
#undef RESC
}
#undef SBAR
#undef KSWZ
}

constexpr int DM = 1024, MTOK = 49152, NPROMPT = 16384, TP = 4096, TS = 2048, NCB = 20, FFH = 2816, INC = 4096;
constexpr size_t MiB = 1u << 20;
constexpr size_t WS_WIN = 0, WS_WOUT = 8 * MiB, WS_W1 = 10 * MiB, WS_W2 = 21 * MiB;
constexpr size_t WS_MOD = 27 * MiB;
constexpr size_t WS_CTR = 27 * MiB + 983040;
constexpr size_t WS_BAR = 27 * MiB + 983040 + 4096;
constexpr size_t WS_COS = 28 * MiB, WS_SIN = 28 * MiB + 512 * 1024;
constexpr size_t WS_BUFA = 29 * MiB;
constexpr size_t WS_QKV = 125 * MiB;
constexpr size_t WS_Y = WS_QKV + 264 * MiB;
constexpr size_t WS_END = WS_QKV + 384 * MiB;
constexpr int C_Q = 0, C_UF = 512, C_UB = 1024, C_V = 1536, C_G = 2048, C_DQ = 2560, C_DK = 3072, C_DV = 3584;

typedef unsigned short bf16;
typedef unsigned v4u __attribute__((ext_vector_type(4)));
typedef unsigned v2u __attribute__((ext_vector_type(2)));
typedef float f32x4 __attribute__((ext_vector_type(4)));
typedef short bf16x8 __attribute__((ext_vector_type(8)));
typedef short bf16x4 __attribute__((ext_vector_type(4)));
#define LAS __attribute__((address_space(3)))
__device__ __forceinline__ unsigned pk2(float lo, float hi) { return pg8::cvt_pk_bf16(lo, hi); }
__device__ __forceinline__ float bf2f(unsigned short h) { return __uint_as_float((unsigned)h << 16); }
__device__ __forceinline__ float bflo(unsigned w) { return __uint_as_float(w << 16); }
__device__ __forceinline__ float bfhi(unsigned w) { return __uint_as_float(w & 0xffff0000u); }
__device__ __forceinline__ float wave_sum(float v) {
#pragma unroll
    for (int o = 1; o < 64; o <<= 1) v += __shfl_xor(v, o);
    return v;
}

struct Args { const float* in[22]; float* out; unsigned char* ws; int ph_lo, ph_hi, xr, pad; };

namespace hg {
constexpr int RS = 272;
constexpr int OFF_QT = 0, OFF_KD = 32 * RS, OFF_KET = 2 * 32 * RS, OFF_VT = OFF_KET + 128 * 64, OFF_D = OFF_VT + 128 * 64, BUF = OFF_D + 512;
__device__ __forceinline__ void chain(const Args& a, int layer, int cid, char* lds) {
    int tid_l = threadIdx.x; asm volatile("" : "+v"(tid_l));
    const int tid = tid_l, lane = tid & 63, w = __builtin_amdgcn_readfirstlane(tid >> 6), kc = lane & 15, tg = lane >> 4;
    int cb, hd, dir, T, row0;
    if (cid < 32) { cb = cid >> 3; hd = (cid >> 1) & 3; dir = cid & 1; T = TP; row0 = cb * TP; }
    else { const int c2 = cid - 32; cb = 4 + (c2 >> 3); hd = (c2 >> 1) & 3; dir = c2 & 1; T = TS; row0 = NPROMPT + (cb - 4) * TS; }
    const int k = 16 * w + kc;
    float lb = 0.f;
    if (layer == 1) { const float a0 = a.in[11][(dir * 2 + 0) * 512 + 128 * hd + k], a1 = a.in[11][(dir * 2 + 1) * 512 + 128 * hd + k]; lb = 1.0f / (1.0f + __expf(a0 - a1)); }
    const float lbf = fmaxf(lb, 1e-30f), oml = 1.0f - lb;
    bf16* QKV = (bf16*)(a.ws + WS_QKV);
    const bf16* qp = QKV + C_Q + 128 * hd; const bf16* up = QKV + C_UF + 512 * dir + 128 * hd; const bf16* vp = QKV + C_V + 128 * hd;
    bf16* op = QKV + C_UF + 512 * dir + 128 * hd;
    const int c = lane & 15, g = lane >> 4;
    unsigned toff[8], ooff[8];
#pragma unroll
    for (int j = 0; j < 8; ++j) { const int tau = 8 * tg + j; toff[j] = (unsigned)((dir ? 31 - tau : tau) * INC + k);
        const int to = 16 * (j >> 2) + 4 * g + (j & 3); ooff[j] = (unsigned)((dir ? 31 - to : to) * INC + 16 * w + c); }
    const int NS = T / 32;
    unsigned rq[2][8], ru[2][8], rv[2][8];
#define HG_RB(i) ((size_t)(row0 + (dir ? (T - 32 - 32 * (i)) : 32 * (i))) * INC)
#define HG_LOAD(s_, i) do { const bf16* q_ = qp + HG_RB(i); const bf16* u_ = up + HG_RB(i); const bf16* v_ = vp + HG_RB(i); _Pragma("unroll") for (int j = 0; j < 8; ++j) { rq[s_][j] = q_[toff[j]]; ru[s_][j] = u_[toff[j]]; rv[s_][j] = v_[toff[j]]; } } while (0)
#define HG_PREP(s_, bufp) do { char* B_ = (bufp); float kk[8], pl[8]; \
          \
        _Pragma("unroll") for (int j = 0; j < 8; ++j) { asm volatile("" : "+v"(rq[s_][j]), "+v"(ru[s_][j]), "+v"(rv[s_][j])); } \
        _Pragma("unroll") for (int j = 0; j < 8; ++j) { const float uu = __uint_as_float(ru[s_][j] << 16); kk[j] = oml * uu; const float f = fmaxf(lbf + (oml - kk[j]), 9.765625e-4f); pl[j] = (j == 0) ? f : pl[j - 1] * f; } \
        const float G = pl[7]; float s1 = __shfl_up(G, 16); if (tg < 1) s1 = 1.f; const float i2 = G * s1; float s2 = __shfl_up(i2, 32); if (tg < 2) s2 = 1.f; const float incl = i2 * s2; \
        float E = __shfl_up(incl, 16); if (tg == 0) E = 1.f; const float Pend = __shfl(incl, 48 + kc); float ke[8]; \
        _Pragma("unroll") for (int j = 0; j < 8; ++j) { const float P = fmaxf(E * pl[j], 1e-30f); const float rP = __builtin_amdgcn_rcpf(P); const float qt = __uint_as_float(rq[s_][j] << 16) * P; const float kd = kk[j] * rP; ke[j] = kd * Pend; \
            *(unsigned short*)(B_ + OFF_QT + (8 * tg + j) * RS + k * 2) = (unsigned short)(pk2(qt, qt) & 0xffffu); *(unsigned short*)(B_ + OFF_KD + (8 * tg + j) * RS + k * 2) = (unsigned short)(pk2(kd, kd) & 0xffffu); } \
        v4u kw; kw.x = pk2(ke[0], ke[1]); kw.y = pk2(ke[2], ke[3]); kw.z = pk2(ke[4], ke[5]); kw.w = pk2(ke[6], ke[7]); *(v4u*)(B_ + OFF_KET + k * 64 + tg * 16) = kw; \
        v4u vw; vw.x = rv[s_][0] | (rv[s_][1] << 16); vw.y = rv[s_][2] | (rv[s_][3] << 16); vw.z = rv[s_][4] | (rv[s_][5] << 16); vw.w = rv[s_][6] | (rv[s_][7] << 16); \
        *(v4u*)(B_ + OFF_VT + k * 64 + tg * 16) = vw; \
        if (tg == 0) *(float*)(B_ + OFF_D + k * 4) = Pend; } while (0)
    f32x4 S[8];
#pragma unroll
    for (int i = 0; i < 8; ++i) S[i] = (f32x4){0.f, 0.f, 0.f, 0.f};
    const f32x4 z4 = (f32x4){0.f, 0.f, 0.f, 0.f};
    HG_LOAD(0, 0); HG_PREP(0, lds); HG_LOAD(1, 1);
    __syncthreads();
    const bool prep_first = (w < 4);
    for (int i2_ = 0; i2_ < NS; i2_ += 2) {
#pragma unroll
      for (int s = 0; s < 2; ++s) {
        const int i = i2_ + s;
        char* cur = lds + s * BUF; char* nxt = lds + (s ^ 1) * BUF;
        if (prep_first) { if (i + 1 < NS) { HG_PREP(s ^ 1, nxt); if (i + 2 < NS) HG_LOAD(s, i + 2); } }
        f32x4 st00 = z4, st01 = z4, st11 = z4;
        { bf16x8 kd0[4], qt0[4], qt1[4], kd1[4];
#pragma unroll
          for (int ks = 0; ks < 4; ++ks) { kd0[ks] = *(const bf16x8*)(cur + OFF_KD + c * RS + ks * 64 + g * 16); qt0[ks] = *(const bf16x8*)(cur + OFF_QT + c * RS + ks * 64 + g * 16); }
#pragma unroll
          for (int ks = 0; ks < 4; ++ks) st00 = __builtin_amdgcn_mfma_f32_16x16x32_bf16(kd0[ks], qt0[ks], st00, 0, 0, 0);
#pragma unroll
          for (int ks = 0; ks < 4; ++ks) qt1[ks] = *(const bf16x8*)(cur + OFF_QT + (16 + c) * RS + ks * 64 + g * 16);
#pragma unroll
          for (int ks = 0; ks < 4; ++ks) st01 = __builtin_amdgcn_mfma_f32_16x16x32_bf16(kd0[ks], qt1[ks], st01, 0, 0, 0);
#pragma unroll
          for (int ks = 0; ks < 4; ++ks) kd1[ks] = *(const bf16x8*)(cur + OFF_KD + (16 + c) * RS + ks * 64 + g * 16);
#pragma unroll
          for (int ks = 0; ks < 4; ++ks) st11 = __builtin_amdgcn_mfma_f32_16x16x32_bf16(kd1[ks], qt1[ks], st11, 0, 0, 0); }
#pragma unroll
        for (int r = 0; r < 4; ++r) if (4 * g + r > c) { st00[r] = 0.f; st11[r] = 0.f; }
        v2u pw; pw.x = pk2(st00[0], st00[1]); pw.y = pk2(st00[2], st00[3]); const bf16x4 pt00 = __builtin_bit_cast(bf16x4, pw);
        pw.x = pk2(st01[0], st01[1]); pw.y = pk2(st01[2], st01[3]); const bf16x4 pt01 = __builtin_bit_cast(bf16x4, pw);
        pw.x = pk2(st11[0], st11[1]); pw.y = pk2(st11[2], st11[3]); const bf16x4 pt11 = __builtin_bit_cast(bf16x4, pw);
        const bf16x4 vt0 = *(const bf16x4*)(cur + OFF_VT + (16 * w + c) * 64 + g * 8);
        const bf16x4 vt1 = *(const bf16x4*)(cur + OFF_VT + (16 * w + c) * 64 + 32 + g * 8);
        f32x4 o0 = __builtin_amdgcn_mfma_f32_16x16x16bf16_1k(pt00, vt0, z4, 0, 0, 0);
        f32x4 o1 = __builtin_amdgcn_mfma_f32_16x16x16bf16_1k(pt01, vt0, z4, 0, 0, 0);
        o1 = __builtin_amdgcn_mfma_f32_16x16x16bf16_1k(pt11, vt1, o1, 0, 0, 0);
#pragma unroll
        for (int kt = 0; kt < 8; ++kt) { const bf16x4 a0 = *(const bf16x4*)(cur + OFF_QT + c * RS + kt * 32 + g * 8); const bf16x4 a1 = *(const bf16x4*)(cur + OFF_QT + (16 + c) * RS + kt * 32 + g * 8);
            v2u sw; sw.x = pk2(S[kt][0], S[kt][1]); sw.y = pk2(S[kt][2], S[kt][3]); const bf16x4 sb = __builtin_bit_cast(bf16x4, sw);
            o0 = __builtin_amdgcn_mfma_f32_16x16x16bf16_1k(a0, sb, o0, 0, 0, 0); o1 = __builtin_amdgcn_mfma_f32_16x16x16bf16_1k(a1, sb, o1, 0, 0, 0); }
        { bf16* o_ = op + HG_RB(i);
#pragma unroll
          for (int r = 0; r < 4; ++r) { const unsigned w0 = pk2(o0[r], o0[r]), w1 = pk2(o1[r], o1[r]); o_[ooff[r]] = (unsigned short)(w0 & 0xffffu); o_[ooff[4 + r]] = (unsigned short)(w1 & 0xffffu); } }
        { const bf16x8 vb = *(const bf16x8*)(cur + OFF_VT + (16 * w + c) * 64 + g * 16);
#pragma unroll
          for (int kt = 0; kt < 8; ++kt) { const f32x4 d4 = *(const f32x4*)(cur + OFF_D + (16 * kt + 4 * g) * 4); const bf16x8 af = *(const bf16x8*)(cur + OFF_KET + (16 * kt + c) * 64 + g * 16);
              S[kt] = __builtin_amdgcn_mfma_f32_16x16x32_bf16(af, vb, S[kt] * d4, 0, 0, 0); } }
        if (!prep_first) { if (i + 1 < NS) { HG_PREP(s ^ 1, nxt); if (i + 2 < NS) HG_LOAD(s, i + 2); } }
        __syncthreads();
      }
    }
#undef HG_RB
#undef HG_LOAD
#undef HG_PREP
}
__device__ __forceinline__ void combine_rows(const Args& a, int layer, int gw, int NGW, int lane) {
    const bf16* QKV = (const bf16*)(a.ws + WS_QKV); bf16* MIX = (bf16*)(a.ws + WS_BUFA);
    const float* gn = a.in[12] + layer * 128 + (lane & 15) * 8; float gw8[8];
#pragma unroll
    for (int e = 0; e < 8; ++e) gw8[e] = gn[e];
    for (int m = gw; m < MTOK; m += NGW) {
        const bf16* rowp = QKV + (size_t)m * INC + lane * 8;
        const v4u f = *(const v4u*)(rowp + C_UF), b = *(const v4u*)(rowp + C_UB), gg = *(const v4u*)(rowp + C_G);
        float o[8]; float ss = 0.f;
#pragma unroll
        for (int e = 0; e < 4; ++e) { o[2 * e] = bflo(f[e]) + bflo(b[e]); o[2 * e + 1] = bfhi(f[e]) + bfhi(b[e]); ss += o[2 * e] * o[2 * e] + o[2 * e + 1] * o[2 * e + 1]; }
        ss += __shfl_xor(ss, 1); ss += __shfl_xor(ss, 2); ss += __shfl_xor(ss, 4); ss += __shfl_xor(ss, 8);
        const float rs = __builtin_amdgcn_rsqf(ss * (1.0f / 128.0f) + 1e-6f);
        v4u w;
#pragma unroll
        for (int e = 0; e < 4; ++e) w[e] = pk2(o[2 * e] * rs * gw8[2 * e] * pg8::silu_f(bflo(gg[e])), o[2 * e + 1] * rs * gw8[2 * e + 1] * pg8::silu_f(bfhi(gg[e])));
        *(v4u*)(MIX + (size_t)m * DM + lane * 8) = w;
    }
}
}

__device__ __forceinline__ void rowpass(const Args& a, int layer, int which, int gw, int NGW, int lane) {
    float* xo = a.out; bf16* XR = (bf16*)(a.ws + WS_END); bf16* H = (bf16*)(a.ws + WS_BUFA); const bf16* Y = (const bf16*)(a.ws + WS_Y); const float* MOD = (const float*)(a.ws + WS_MOD);
    const int c0 = 4 * lane;
    const bool from_in = (which == 0 || (which == 1 && layer == 0));
    const bool src16 = a.xr && !from_in, dst16 = a.xr && !(which == 2 && layer == 1);
    f32x4 wpost[4], wpre[4];
    const float* wpostp = (which == 1) ? a.in[7] + layer * DM : a.in[9] + layer * DM;
    const int hl = (which == 2) ? layer + 1 : layer;
    const float* wprep = (which == 1) ? a.in[8] + layer * DM : a.in[6] + (hl < 2 ? hl : 0) * DM;
    const bool do_h = !(which == 2 && layer == 1);
#pragma unroll
    for (int j = 0; j < 4; ++j) { wpost[j] = *(const f32x4*)(wpostp + c0 + 256 * j); wpre[j] = *(const f32x4*)(wprep + c0 + 256 * j); }
    const int rpw = ((MTOK + NGW - 1) / NGW + 7) & ~7; const int mbeg = gw * rpw, mend = (mbeg + rpw < MTOK) ? mbeg + rpw : MTOK;
    f32x4 gt[4], sh[4], scl[4]; int cbl = -1;
    constexpr int RG = 4;
    for (int m0 = mbeg; m0 < mend; m0 += RG) {
        const int cb = m0 < NPROMPT ? (m0 >> 12) : 4 + ((m0 - NPROMPT) >> 11);
        if (cb != cbl) { cbl = cb;
            const float* modp = MOD + (size_t)(layer * NCB + cb) * 6144 + (which == 1 ? 2048 : 5120);
            const float* modh = MOD + (size_t)((hl < 2 ? hl : 0) * NCB + cb) * 6144 + (which == 1 ? 3072 : 0);
#pragma unroll
            for (int j = 0; j < 4; ++j) { gt[j] = *(const f32x4*)(modp + c0 + 256 * j); sh[j] = *(const f32x4*)(modh + c0 + 256 * j); scl[j] = *(const f32x4*)(modh + 1024 + c0 + 256 * j) + 1.0f; } }
        f32x4 x[RG][4]; v2u yr[RG][4]; int mq[RG];
#pragma unroll
        for (int q = 0; q < RG; ++q) { const int m = (m0 + q < mend) ? m0 + q : m0; mq[q] = m;
            if (src16) {
#pragma unroll
                for (int j = 0; j < 4; ++j) { const v2u xw = *(const v2u*)(XR + (size_t)m * DM + c0 + 256 * j); x[q][j] = (f32x4){bflo(xw.x), bfhi(xw.x), bflo(xw.y), bfhi(xw.y)}; }
            } else {
                const float* xin = from_in ? (m < NPROMPT ? a.in[0] + (size_t)m * DM : a.in[1] + (size_t)(m - NPROMPT) * DM) : xo + (size_t)m * DM;
#pragma unroll
                for (int j = 0; j < 4; ++j) x[q][j] = *(const f32x4*)(xin + c0 + 256 * j);
            }
            if (which != 0) {
#pragma unroll
                for (int j = 0; j < 4; ++j) yr[q][j] = *(const v2u*)(Y + (size_t)m * DM + c0 + 256 * j); } }
        if (which != 0) {
            float ss[RG]; f32x4 y[RG][4];
#pragma unroll
            for (int q = 0; q < RG; ++q) { ss[q] = 0.f;
#pragma unroll
                for (int j = 0; j < 4; ++j) { const v2u yw = yr[q][j]; y[q][j] = (f32x4){bflo(yw.x), bfhi(yw.x), bflo(yw.y), bfhi(yw.y)};
                    ss[q] += (y[q][j].x * y[q][j].x + y[q][j].y * y[q][j].y) + (y[q][j].z * y[q][j].z + y[q][j].w * y[q][j].w); } }
#pragma unroll
            for (int o = 1; o < 64; o <<= 1) {
#pragma unroll
                for (int q = 0; q < RG; ++q) ss[q] += __shfl_xor(ss[q], o); }
#pragma unroll
            for (int q = 0; q < RG; ++q) { const float r = __builtin_amdgcn_rsqf(ss[q] * (1.0f / DM) + 1e-6f);
#pragma unroll
                for (int j = 0; j < 4; ++j) { x[q][j] = x[q][j] + gt[j] * (y[q][j] * r * wpost[j]);
                    if (dst16) { v2u w; w.x = pk2(x[q][j].x, x[q][j].y); w.y = pk2(x[q][j].z, x[q][j].w); *(v2u*)(XR + (size_t)mq[q] * DM + c0 + 256 * j) = w; }
                    else *(f32x4*)(xo + (size_t)mq[q] * DM + c0 + 256 * j) = x[q][j]; } }
        }
        if (do_h) {
            float ss[RG];
#pragma unroll
            for (int q = 0; q < RG; ++q) { ss[q] = 0.f;
#pragma unroll
                for (int j = 0; j < 4; ++j) ss[q] += (x[q][j].x * x[q][j].x + x[q][j].y * x[q][j].y) + (x[q][j].z * x[q][j].z + x[q][j].w * x[q][j].w); }
#pragma unroll
            for (int o = 1; o < 64; o <<= 1) {
#pragma unroll
                for (int q = 0; q < RG; ++q) ss[q] += __shfl_xor(ss[q], o); }
#pragma unroll
            for (int q = 0; q < RG; ++q) { const float r = __builtin_amdgcn_rsqf(ss[q] * (1.0f / DM) + 1e-6f);
#pragma unroll
                for (int j = 0; j < 4; ++j) { const f32x4 h = x[q][j] * r * wpre[j] * scl[j] + sh[j]; v2u w; w.x = pk2(h.x, h.y); w.y = pk2(h.z, h.w); *(v2u*)(H + (size_t)mq[q] * DM + c0 + 256 * j) = w; } }
        }
    }
}

__device__ __forceinline__ void transpose_item(const float* W, int K, int N, bf16* WT, int dn0, int sn0, int k0, LAS float* scr, int lane) {
#pragma unroll 8
    for (int i = 0; i < 32; ++i) { const int kk = 2 * i + (lane >> 5); scr[kk * 33 + (lane & 31)] = W[(size_t)(k0 + kk) * N + sn0 + (lane & 31)]; }
    asm volatile("s_waitcnt lgkmcnt(0)" ::: "memory");
    const int c = lane & 7;
#pragma unroll
    for (int j = 0; j < 4; ++j) { const int n = (lane >> 3) + 8 * j; const LAS float* s = scr + (8 * c) * 33 + n;
        v4u o; o.x = pk2(s[0 * 33], s[1 * 33]); o.y = pk2(s[2 * 33], s[3 * 33]); o.z = pk2(s[4 * 33], s[5 * 33]); o.w = pk2(s[6 * 33], s[7 * 33]);
        *(v4u*)(WT + (size_t)(dn0 + n) * K + k0 + 8 * c) = o; }
    asm volatile("s_waitcnt lgkmcnt(0)" ::: "memory");
}
__device__ __forceinline__ void convert_weights(const Args& a, int layer, LAS unsigned char* lds, int gw, int NGW, int wave, int lane) {
    LAS float* scr = (LAS float*)(lds + wave * 16384);
    constexpr int I_IN = 16 * 128, I_OUT = 16 * 32, I_1 = 16 * 176, I_2 = 44 * 32, NITEMS = I_IN + I_OUT + I_1 + I_2;
    bf16* WinT = (bf16*)(a.ws + WS_WIN); bf16* WoutT = (bf16*)(a.ws + WS_WOUT); bf16* W1T = (bf16*)(a.ws + WS_W1); bf16* W2T = (bf16*)(a.ws + WS_W2);
    for (int it = gw; it < NITEMS; it += NGW) {
        int r = it;
        if (r < I_IN) { const int kb = r / 128, nb = r % 128, dn0 = nb * 32; int sn0 = dn0; const int blk = dn0 / 512;
            if (blk == 5 || blk == 6) { const int tile = dn0 / 256, g = dn0 % 256, half = g / 128, head = (g % 128) / 32; sn0 = tile * 256 + head * 64 + half * 32; }
            transpose_item(a.in[10] + (size_t)layer * DM * INC, DM, INC, WinT, dn0, sn0, kb * 64, scr, lane); continue; } r -= I_IN;
        if (r < I_OUT) { const int kb = r / 32, nb = r % 32; transpose_item(a.in[18] + (size_t)layer * DM * DM, DM, DM, WoutT, nb * 32, nb * 32, kb * 64, scr, lane); continue; } r -= I_OUT;
        if (r < I_1) { const int kb = r / 176, nb = r % 176, dn0 = nb * 32; const int pn = dn0 / 256, bj = (dn0 % 256) / 128, x = dn0 % 128;
            transpose_item((bj ? a.in[20] : a.in[19]) + (size_t)layer * DM * FFH, DM, FFH, W1T, dn0, 128 * pn + x, kb * 64, scr, lane); continue; } r -= I_1;
        { const int kb = r / 32, nb = r % 32; transpose_item(a.in[21] + (size_t)layer * FFH * DM, FFH, DM, W2T, nb * 32, nb * 32, kb * 64, scr, lane); }
    }
}
__device__ __forceinline__ void mod_item(const Args& a, int item, LAS unsigned char* lds, int tid, int wave, int lane) {
    LAS float* sc = (LAS float*)lds; LAS float* red = (LAS float*)(lds + 81920);
    const int l = item / 96, n0 = (item % 96) * 64;
    for (int i = tid; i < NCB * DM; i += 512) { const int cb = i >> 10, k = i & 1023; const float v = cb < 4 ? a.in[2][cb * DM + k] : a.in[3][(cb - 4) * DM + k];
        sc[i] = v / (1.0f + __expf(-v)); }
    __syncthreads();
    float acc[NCB];
#pragma unroll
    for (int cb = 0; cb < NCB; ++cb) acc[cb] = 0.f;
    const float* wp = a.in[4] + (size_t)l * DM * 6144 + n0 + lane;
    for (int k0 = wave * 128; k0 < wave * 128 + 128; k0 += 16) {
        float wv[16];
#pragma unroll
        for (int i = 0; i < 16; ++i) wv[i] = wp[(size_t)(k0 + i) * 6144];
#pragma unroll
        for (int i = 0; i < 16; ++i) {
#pragma unroll
            for (int cb = 0; cb < NCB; ++cb) acc[cb] += sc[cb * DM + k0 + i] * wv[i]; } }
#pragma unroll
    for (int cb = 0; cb < NCB; ++cb) red[(wave * NCB + cb) * 64 + lane] = acc[cb];
    __syncthreads();
    float* MOD = (float*)(a.ws + WS_MOD);
    for (int i = tid; i < NCB * 64; i += 512) { const int cb = i >> 6, ln = i & 63; float s = a.in[5][l * 6144 + n0 + ln];
#pragma unroll
        for (int w = 0; w < 8; ++w) s += red[(w * NCB + cb) * 64 + ln];
        MOD[(size_t)(l * NCB + cb) * 6144 + n0 + ln] = s; }
    __syncthreads();
}

#define XB_TMO      128
#define XB_XCNT(j)  (256  + 64 * (j))
#define XB_XSUB(j)  (1280 + 64 * (j))
#define XB_XGEN(j)  (2304 + 64 * (j))
#define XB_TOP      3328
#define XB_TOPGEN   3392
#define XCD_BAR_WORDS 3456
#define XB_SPIN_CAP (1u << 18)

__device__ __forceinline__ unsigned xb_ld(unsigned* p)              { return __hip_atomic_load(p, __ATOMIC_RELAXED, __HIP_MEMORY_SCOPE_AGENT); }
__device__ __forceinline__ unsigned xb_add(unsigned* p, unsigned v) { return __hip_atomic_fetch_add(p, v, __ATOMIC_RELAXED, __HIP_MEMORY_SCOPE_AGENT); }
__device__ __forceinline__ unsigned xb_xcc_id() { return (unsigned)__builtin_amdgcn_s_getreg((3 << 11) | 20) & 0xFu; }
#define XB_SPIN(cond, bar) do { unsigned _sp = 0; while (cond) { __builtin_amdgcn_s_sleep(1); \
    if ((++_sp & 255u) == 0u) { if (xb_ld(&(bar)[XB_TMO])) break; if (_sp > XB_SPIN_CAP) { atomicAdd(&(bar)[XB_TMO], 1u); break; } } } } while (0)

struct XcdBarrier {
    unsigned* bar; unsigned x;
    volatile LAS unsigned* st;
};

__device__ __forceinline__ XcdBarrier xcd_barrier_post(unsigned* bar, volatile LAS unsigned* st) {
    XcdBarrier b; b.bar = bar; b.x = xb_xcc_id(); b.st = st;
    if (threadIdx.x == 0) (void)xb_add(&bar[XB_XCNT(b.x)], 1u);
    return b;
}
__device__ __forceinline__ void xcd_barrier_complete(unsigned* bar, unsigned x, unsigned& nloc, unsigned& nx) {
    const unsigned G = gridDim.x * gridDim.y * gridDim.z;
    unsigned sum, cnt, mine, sp = 0u;
    for (;;) {
        sum = 0u; cnt = 0u; mine = 0u;
#pragma unroll
        for (unsigned j = 0; j < 16; ++j) { const unsigned c = xb_ld(&bar[XB_XCNT(j)]); sum += c; cnt += (c > 0u) ? 1u : 0u; mine = (j == x) ? c : mine; }
        if (sum == G) break;
        __builtin_amdgcn_s_sleep(1);
        if ((++sp & 255u) == 0u) { if (xb_ld(&bar[XB_TMO])) break; if (sp > XB_SPIN_CAP) { atomicAdd(&bar[XB_TMO], 1u); break; } }
    }
    nloc = mine > 0u ? mine : 1u; nx = cnt > 0u ? cnt : 1u;
}

__device__ __forceinline__ void xcd_barrier(const XcdBarrier& b) {
    asm volatile("s_waitcnt vmcnt(0)" ::: "memory");
    __syncthreads();
    if (threadIdx.x == 0) {
        unsigned* bar = b.bar;
        __builtin_amdgcn_s_waitcnt(0);
        unsigned nloc = b.st[0], nx = b.st[1];
        if (nloc == 0u) { xcd_barrier_complete(bar, b.x, nloc, nx); b.st[0] = nloc; b.st[1] = nx; }
        const unsigned old = xb_add(&bar[XB_XSUB(b.x)], 1u);
        const unsigned gen = old / nloc;
        if (old + 1u == (gen + 1u) * nloc) {
            __builtin_amdgcn_fence(__ATOMIC_RELEASE, "agent");
            asm volatile("s_waitcnt vmcnt(0)" ::: "memory");
            const unsigned og = xb_add(&bar[XB_TOP], 1u);
            const unsigned tg = og / nx;
            if (og + 1u == (tg + 1u) * nx) xb_add(&bar[XB_TOPGEN], 1u);
            else XB_SPIN(xb_ld(&bar[XB_TOPGEN]) == tg, bar);
            __builtin_amdgcn_fence(__ATOMIC_ACQUIRE, "agent");
            xb_add(&bar[XB_XGEN(b.x)], 1u);
            asm volatile("s_waitcnt vmcnt(0)" ::: "memory");
        } else {
            XB_SPIN(xb_ld(&bar[XB_XGEN(b.x)]) == gen, bar);
            __builtin_amdgcn_fence(__ATOMIC_ACQUIRE, "agent");
            asm volatile("s_waitcnt vmcnt(0)" ::: "memory");
        }
    }
    __syncthreads();
}

constexpr int LDS_BYTES = 147456;
constexpr int NPH = 18;
#ifndef REP_ATT
#define REP_ATT 1
#endif
#ifndef REP_GEMM
#define REP_GEMM 1
#endif
#ifndef REP_PRO
#define REP_PRO 1
#endif
#ifndef REP_ROW0
#define REP_ROW0 1
#endif
#ifndef EXTRA_SYNC
#define EXTRA_SYNC 0
#endif
#ifndef REP_HGC
#define REP_HGC 1
#endif
__global__ void __launch_bounds__(512, 2) mega_fwd(Args a) {
    extern __shared__ __attribute__((aligned(16))) unsigned char lds[];
    cg::grid_group grid = cg::this_grid();
    const int tid = threadIdx.x, lane = tid & 63, wave = __builtin_amdgcn_readfirstlane(tid >> 6);
    const int G = gridDim.x, bx = blockIdx.x;
    const int vcu = (G % 8 == 0) ? (bx % 8) * (G / 8) + bx / 8 : bx;
    const int gw = vcu * 8 + wave, NGW = G * 8;
    LAS unsigned char* lds3 = (LAS unsigned char*)lds;
    const int lo = a.ph_lo, hi = a.ph_hi;
    if (tid < 8) ((LAS unsigned*)(lds3 + LDS_BYTES - 32))[tid] = 0u;
    __syncthreads();
    XcdBarrier bar; bar.bar = (unsigned*)(a.ws + WS_BAR); bar.x = 0; bar.st = (volatile LAS unsigned*)(lds3 + LDS_BYTES - 32);
#define IN(k) (lo <= (k) && (k) < hi)
#define SEAM(k) do { if ((k) + 1 < hi) { if ((k) == 0) { grid.sync(); bar = xcd_barrier_post((unsigned*)(a.ws + WS_BAR), (volatile LAS unsigned*)(lds3 + LDS_BYTES - 32)); } else xcd_barrier(bar); } } while (0)
    bf16* BUFA = (bf16*)(a.ws + WS_BUFA); bf16* QKV = (bf16*)(a.ws + WS_QKV); bf16* YB = (bf16*)(a.ws + WS_Y);
    const float* cosT = (const float*)(a.ws + WS_COS); const float* sinT = (const float*)(a.ws + WS_SIN);

    if (IN(0)) {
      for (int rep = 0; rep < REP_PRO; ++rep) {
        int ln = lane, td = tid; asm volatile("" : "+v"(ln), "+v"(td));

#ifndef NO_MOD
        for (int item = bx; item < 192; item += G) mod_item(a, item, lds3, td, wave, ln);
#endif

        for (int gt = bx * 512 + td; gt < 4096 * 32; gt += G * 512) { { const int t = gt >> 5, i = gt & 31;
            const float inv = __builtin_amdgcn_exp2f(-(float)i * (13.287712379549449f / 32.0f));
            float rev = (float)t * inv * 0.15915494309189535f; rev = rev - floorf(rev);
            ((float*)(a.ws + WS_COS))[gt] = __builtin_amdgcn_cosf(rev); ((float*)(a.ws + WS_SIN))[gt] = __builtin_amdgcn_sinf(rev); } }
        if (bx == 0 && td < 16) ((unsigned*)(a.ws + WS_CTR))[64 * td] = 0u;
        if (bx == 0) for (int i = td; i < XCD_BAR_WORDS; i += 512) ((unsigned*)(a.ws + WS_BAR))[i] = 0u;
        convert_weights(a, 0, lds3, gw, NGW, wave, ln);
        __syncthreads();
      }
        for (int e = 0; e < EXTRA_SYNC; ++e) grid.sync();
        SEAM(0);
    }
    if (IN(1)) { for (int rep = 0; rep < REP_ROW0; ++rep) { int ln = lane; asm volatile("" : "+v"(ln)); rowpass(a, 0, 0, gw, NGW, ln); } SEAM(1); }
#pragma unroll 1
    for (int layer = 0; layer < 2; ++layer) {
        const int pb = 2 + 8 * layer;
        if (IN(pb + 0)) {
            pg8::Gemm g{BUFA, (const bf16*)(a.ws + WS_WIN), MTOK, INC, DM}; pg8::StaticOrder S; S.init(MTOK, INC, G, bx);
            pg8::EpiIn E{QKV, INC, cosT, sinT, 0.125f * 1.4426950408889634f};

#ifndef NO_GIN
            for (int rep = 0; rep < REP_GEMM; ++rep) pg8::gemm_phase<pg8::EpiIn, pg8::StaticOrder, true, true>(lds3, g, S, E);
#endif

            SEAM(pb + 0);
        }
        if (IN(pb + 1)) {
            int ln = lane; asm volatile("" : "+v"(ln));
            float s1 = a.in[13][layer * 64 + ln] * a.in[14][layer * 64 + ln], s2 = a.in[15][layer * 64 + ln] * a.in[16][layer * 64 + ln];
            s1 = wave_sum(s1); s2 = wave_sum(s2);
            const float linit = 0.8f - 0.6f * __expf(-0.3f * (float)layer);
            const float lam = __expf(s1) - __expf(s2) + linit, post = 1.0f - linit;
            const float* subln = a.in[17] + layer * 128;
            unsigned* ctr = (unsigned*)(a.ws + WS_CTR) + 64 * 8 * layer;
            volatile LAS unsigned* qslot = (volatile LAS unsigned*)(lds3 + LDS_BYTES - 64);
            int myq = (int)(xb_xcc_id() & 7u), adv = 0;
            constexpr int QLEN = 20 + 64 + 128;
            for (;;) {
                __syncthreads();
                if (tid == 0) { unsigned v = 0xffffffffu;
                    while (adv < 8) { v = __hip_atomic_fetch_add(ctr + 64 * myq, 1u, __ATOMIC_RELAXED, __HIP_MEMORY_SCOPE_AGENT); if (v < (unsigned)QLEN) break; v = 0xffffffffu; myq = (myq + 1) & 7; ++adv; }
                    *qslot = (v == 0xffffffffu) ? v : (((unsigned)myq << 16) | v); }
                __syncthreads();
                const unsigned qw = *qslot;
                if (qw == 0xffffffffu) break;
                const int qx = (int)(qw >> 16), li = (int)(qw & 0xffffu);
                int idx;
                if (li < 4) idx = qx * 4 + li;
                else if (li < 20) idx = 32 + qx * 16 + (li - 4);
                else if (li < 84) { const int j = li - 20; idx = 160 + (qx + 8 * (j >> 5)) * 32 + (j & 31); }
                else { const int j = li - 84; idx = 160 + 512 + (qx + 8 * (j >> 4)) * 16 + (j & 15); }
                if (idx < 160) {
#ifndef NO_HG
                    hg::chain(a, layer, idx, (char*)lds);
#endif
                } else {
                    const int u = idx - 160; int cb, hd, qb, T, row0;
                    if (u < 512) { cb = u >> 7; hd = (u >> 5) & 3; qb = u & 31; T = TP; row0 = cb * TP; }
                    else { const int u2 = u - 512; cb = 4 + (u2 >> 6); hd = (u2 >> 4) & 3; qb = u2 & 15; T = TS; row0 = NPROMPT + (cb - 4) * TS; }
                    const bf16* Qb = QKV + (size_t)(row0 + qb * 128) * INC + C_DQ + 128 * hd;
                    const bf16* Kh = QKV + (size_t)row0 * INC + C_DK + 128 * hd; const bf16* Vh = QKV + (size_t)row0 * INC + C_DV + 128 * hd;
                    bf16* Ob = BUFA + (size_t)(row0 + qb * 128) * DM + 512 + 128 * hd;
#ifndef NO_ATT
                    for (int rep = 0; rep < REP_ATT; ++rep) att::attn_unit(Qb, Kh, Vh, Ob, T, (char*)lds, lam, post, subln);
#endif
                }
            }
            SEAM(pb + 1);
        }
        if (IN(pb + 2)) { int ln = lane; asm volatile("" : "+v"(ln)); hg::combine_rows(a, layer, gw, NGW, ln); SEAM(pb + 2); }
        if (IN(pb + 3)) {
            pg8::Gemm g{BUFA, (const bf16*)(a.ws + WS_WOUT), MTOK, DM, DM}; pg8::StaticOrder S; S.init(MTOK, DM, G, bx);
            pg8::EpiPlain E{YB, DM};

#ifndef NO_GPL
            for (int rep = 0; rep < REP_GEMM; ++rep) pg8::gemm_phase<pg8::EpiPlain, pg8::StaticOrder, true, true>(lds3, g, S, E);
#endif

            SEAM(pb + 3);
        }
        if (IN(pb + 4)) { int ln = lane; asm volatile("" : "+v"(ln)); rowpass(a, layer, 1, gw, NGW, ln); SEAM(pb + 4); }
        if (IN(pb + 5)) {
            pg8::Gemm g{BUFA, (const bf16*)(a.ws + WS_W1), MTOK, 2 * FFH, DM}; pg8::StaticOrder S; S.init(MTOK, 2 * FFH, G, bx);
            pg8::EpiSwiGLU E{QKV, FFH};

#ifndef NO_GSW
            for (int rep = 0; rep < REP_GEMM; ++rep) pg8::gemm_phase<pg8::EpiSwiGLU, pg8::StaticOrder, true, true>(lds3, g, S, E);
#endif

            SEAM(pb + 5);
        }
        if (IN(pb + 6)) {
            pg8::Gemm g{QKV, (const bf16*)(a.ws + WS_W2), MTOK, DM, FFH}; pg8::StaticOrder S; S.init(MTOK, DM, G, bx, 1);
            pg8::EpiPlain E{YB, DM};

#ifndef NO_GPL
            for (int rep = 0; rep < REP_GEMM; ++rep) pg8::gemm_phase<pg8::EpiPlain, pg8::StaticOrder, true, true>(lds3, g, S, E);
#endif

            SEAM(pb + 6);
        }
        if (IN(pb + 7)) {
            int ln = lane; asm volatile("" : "+v"(ln));
            rowpass(a, layer, 2, gw, NGW, ln);
            if (layer == 0) convert_weights(a, 1, lds3, gw, NGW, wave, ln);
            SEAM(pb + 7);
        }
    }
#undef IN
#undef SEAM
}


#ifndef DBG_STOP
#define DBG_STOP 0
#endif
#ifndef DBG_DUMP
#define DBG_DUMP 0
#endif
__global__ void dbg_dump(Args a, int which) {
    const size_t n = (size_t)MTOK * DM;
    for (size_t i = (size_t)blockIdx.x * blockDim.x + threadIdx.x; i < n; i += (size_t)gridDim.x * blockDim.x) {
        const size_t m = i >> 10, c = i & 1023; float v = 0.f;
        if (which == 1) { const bf16* q = (const bf16*)(a.ws + WS_QKV) + m * INC + c; v = bf2f(q[0]) + bf2f(q[1024]) + bf2f(q[2048]) + bf2f(q[3072]); }
        else if (which == 2) v = bf2f(((const bf16*)(a.ws + WS_BUFA))[i]);
        else if (which == 3) v = bf2f(((const bf16*)(a.ws + WS_Y))[i]);
        a.out[i] = v;
    }
}
#ifndef MK_MULTI
#define MK_MULTI 0
#endif
extern "C" void kernel_launch(void* const* d_in, const int* in_sizes, int n_in, void* d_out, int out_size, void* d_ws, size_t ws_size, hipStream_t stream) {
    static int grid = 0;
    if (grid == 0) {
        if (n_in != 22 || out_size != MTOK * DM || ws_size < WS_END) { fprintf(stderr, "kernel_launch: unexpected shapes: n_in %d out %d ws %zu (need %zu)\n", n_in, out_size, ws_size, (size_t)WS_END); grid = -1; return; }
        int dev = 0, cus = 0, per_cu = 0;
        if (hipGetDevice(&dev) != hipSuccess || hipDeviceGetAttribute(&cus, hipDeviceAttributeMultiprocessorCount, dev) != hipSuccess) { grid = -1; return; }
        if (hipFuncSetAttribute((const void*)mega_fwd, hipFuncAttributeMaxDynamicSharedMemorySize, LDS_BYTES) != hipSuccess) { fprintf(stderr, "kernel_launch: hipFuncSetAttribute failed\n"); grid = -1; return; }
        if (hipOccupancyMaxActiveBlocksPerMultiprocessor(&per_cu, (const void*)mega_fwd, 512, LDS_BYTES) != hipSuccess || per_cu < 1) { fprintf(stderr, "kernel_launch: occupancy query says %d\n", per_cu); per_cu = 1; }
        (void)hipGetLastError();
        grid = cus;
    }
    if (grid < 0) return;
    Args a{};
    for (int i = 0; i < 22; ++i) a.in[i] = (const float*)d_in[i];
    a.out = (float*)d_out; a.ws = (unsigned char*)d_ws; a.xr = (ws_size >= WS_END + (size_t)MTOK * DM * 2) ? 1 : 0;
#if MK_MULTI
    for (int ph = 0; ph < (DBG_STOP ? DBG_STOP : NPH); ++ph) { a.ph_lo = ph; a.ph_hi = ph + 1; hipLaunchKernelGGL(mega_fwd, dim3(grid), dim3(512), LDS_BYTES, stream, a); }
    if (DBG_DUMP) hipLaunchKernelGGL(dbg_dump, dim3(2048), dim3(256), 0, stream, a, DBG_DUMP);
#else
    a.ph_lo = 0; a.ph_hi = NPH;
    void* args[] = {&a};
    hipError_t e = hipLaunchCooperativeKernel((const void*)mega_fwd, dim3(grid), dim3(512), args, LDS_BYTES, stream);
    if (e != hipSuccess) fprintf(stderr, "cooperative launch failed: %s (grid %d)\n", hipGetErrorString(e), grid);
#endif
}
```
